# Optimizing an MI355X kernel written in HIP

```python
import jax
import jax.numpy as jnp
from jax import lax
import numpy as np


D_MODEL = 1024
BATCH = 4
SEQ = 4096
DEPTH = 4

GRID_W = 64
CTX_LEN = 256
EPS = 1e-6

CONV_W = D_MODEL
GLA_HEADS = 4
GLA_DK = D_MODEL // 2 // GLA_HEADS
GLA_DV = D_MODEL // GLA_HEADS
GLA_RANK = 16
GLA_NORMALIZER = 16.0
GLA_CHUNK = 64
MLA_HEADS = 8
MLA_NOPE = 128
MLA_ROPE = 64
MLA_DV = 128
MLA_QK = MLA_NOPE + MLA_ROPE
MLA_Q_RANK = 384
MLA_KV_RANK = 128
ROPE_BASE = 10000.0
Q_BLOCK = 128

IN_LAYOUT = (
    ('a_v', CONV_W), ('a_b', CONV_W), ('a_c', CONV_W), ('a_z', CONV_W),
    ('b_q', GLA_HEADS * GLA_DK), ('b_k', GLA_HEADS * GLA_DK), ('b_v', GLA_HEADS * GLA_DV),
    ('b_z', GLA_HEADS * GLA_DV), ('b_af', GLA_RANK), ('b_ab', GLA_RANK),
    ('c_q', MLA_Q_RANK), ('c_kv', MLA_KV_RANK), ('c_kr', MLA_ROPE), ('c_z', MLA_HEADS * MLA_DV),
    ('g_a', D_MODEL), ('g_b', D_MODEL), ('g_c', D_MODEL),
)
IN_DIM = sum(w for _, w in IN_LAYOUT)

kernel_name = 'hybrid_conv_gla_mla_prefix_trunk'


def _rmsnorm(x, g):
    xf = x.astype(jnp.float32)
    y = xf * lax.rsqrt(jnp.mean(xf * xf, axis=-1, keepdims=True) + EPS)
    return (y * g.astype(jnp.float32)).astype(x.dtype)


def _split_in(u):
    out = {}
    start = 0
    for name, width in IN_LAYOUT:
        out[name] = u[..., start:start + width]
        start += width
    return out


def _axial_rope_tables(n_tokens):
    rows = n_tokens // GRID_W
    row = jnp.repeat(jnp.arange(rows, dtype=jnp.float32), GRID_W)
    col = jnp.tile(jnp.arange(GRID_W, dtype=jnp.float32), rows)
    n_freq = MLA_ROPE // 4
    freqs = ROPE_BASE ** (-jnp.arange(n_freq, dtype=jnp.float32) / n_freq)
    ang_r = row[:, None] * freqs[None, :]
    ang_c = col[:, None] * freqs[None, :]
    ang = jnp.concatenate([ang_r, ang_r, ang_c, ang_c], axis=-1)
    return jnp.cos(ang), jnp.sin(ang)


def _apply_axial_rope(x, cos, sin):
    half = MLA_ROPE // 2
    quarter = MLA_ROPE // 4
    xf = x.astype(jnp.float32)

    def rot(blk):
        return jnp.concatenate([-blk[..., quarter:], blk[..., :quarter]], axis=-1)

    rotated = jnp.concatenate([rot(xf[..., :half]), rot(xf[..., half:])], axis=-1)
    return (xf * cos[:, None, :] + rotated * sin[:, None, :]).astype(x.dtype)


def _short_conv(u, w):
    up = jnp.pad(u, ((0, 0), (1, 1), (0, 0)))
    return up[:, :-2] * w[0] + up[:, 1:-1] * w[1] + up[:, 2:] * w[2]


def _short_conv_mixer(u, conv_w):
    y = u['a_b'] * _short_conv(u['a_c'] * u['a_v'], conv_w)
    return y * jax.nn.silu(u['a_z'])


def _gla_log_decay(h_low, w_up, b):
    z = (h_low @ w_up + b).astype(jnp.float32)
    return jax.nn.log_sigmoid(z) / GLA_NORMALIZER


def _gla_query(u):
    bsz, t = u['b_q'].shape[:2]
    return u['b_q'].reshape(bsz, t, GLA_HEADS, GLA_DK) * (GLA_DK ** -0.5)


def _gla_prepare(u, p):
    bsz, t = u['b_k'].shape[:2]
    k = u['b_k'].reshape(bsz, t, GLA_HEADS, GLA_DK)
    v = u['b_v'].reshape(bsz, t, GLA_HEADS, GLA_DV)
    la_f = _gla_log_decay(u['b_af'], p['gla_wa_up_f'], p['gla_ba_f']).reshape(bsz, t, GLA_HEADS, GLA_DK)
    la_b = _gla_log_decay(u['b_ab'], p['gla_wa_up_b'], p['gla_ba_b']).reshape(bsz, t, GLA_HEADS, GLA_DK)
    return k, v, la_f, la_b


def _gla_chunked(q, k, v, loga, s0):
    bsz, t, h, dk = q.shape
    dv = v.shape[-1]
    n = t // GLA_CHUNK
    shp = (bsz, n, GLA_CHUNK, h)
    qc = q.astype(jnp.float32).reshape(shp + (dk,))
    kc = k.astype(jnp.float32).reshape(shp + (dk,))
    vc = v.astype(jnp.float32).reshape(shp + (dv,))
    b = jnp.cumsum(loga.reshape(shp + (dk,)), axis=2)
    b_last = b[:, :, -1:]
    q_dec = qc * jnp.exp(b)
    k_inv = kc * jnp.exp(-b)
    k_end = kc * jnp.exp(b_last - b)
    mask = jnp.tril(jnp.ones((GLA_CHUNK, GLA_CHUNK), dtype=bool))
    att = jnp.where(mask, jnp.einsum('bnihd,bnjhd->bnhij', q_dec, k_inv), 0.0)
    o_intra = jnp.einsum('bnhij,bnjhe->bnihe', att, vc)
    u = jnp.einsum('bnjhd,bnjhe->nbhde', k_end, vc)
    g = jnp.exp(b_last[:, :, 0]).swapaxes(0, 1)

    def step(s, inp):
        g_n, u_n = inp
        return g_n[..., None] * s + u_n, s

    _, s_start = lax.scan(step, s0, (g, u))
    o_inter = jnp.einsum('bnihd,nbhde->bnihe', q_dec, s_start)
    return (o_intra + o_inter).reshape(bsz, t, h, dv).astype(v.dtype)


def _gla_final_state(k, v, loga):
    cum = jnp.cumsum(loga, axis=1)
    w = jnp.exp(cum[:, -1:] - cum)
    return jnp.einsum('bthd,bthe->bhde', k.astype(jnp.float32) * w, v.astype(jnp.float32))


def _gla_bidir(q, k, v, la_f, la_b, s_f, s_b):
    o_f = _gla_chunked(q, k, v, la_f, s_f)
    o_b = jnp.flip(_gla_chunked(jnp.flip(q, 1), jnp.flip(k, 1), jnp.flip(v, 1), jnp.flip(la_b, 1), s_b), 1)
    return o_f + o_b


def _gla_output(o, z, g):
    bsz, t = o.shape[:2]
    o = _rmsnorm(o.astype(z.dtype), g.reshape(GLA_HEADS, GLA_DV))
    return o.reshape(bsz, t, GLA_HEADS * GLA_DV) * jax.nn.silu(z)


def _mla_q(c_q, p, cos, sin):
    bsz, t = c_q.shape[:2]
    q = (_rmsnorm(c_q, p['mla_q_norm_g']) @ p['mla_wq_up']).reshape(bsz, t, MLA_HEADS, MLA_QK)
    q = _rmsnorm(q, p['mla_qn_g'])
    if cos is not None:
        q = jnp.concatenate([q[..., :MLA_NOPE], _apply_axial_rope(q[..., MLA_NOPE:], cos, sin)], axis=-1)
    return q


def _mla_kv(c_kv, c_kr, p, cos, sin):
    bsz, t = c_kv.shape[:2]
    kv = (_rmsnorm(c_kv, p['mla_kv_norm_g']) @ p['mla_wkv_up']).reshape(bsz, t, MLA_HEADS, MLA_NOPE + MLA_DV)
    k_nope, v = kv[..., :MLA_NOPE], kv[..., MLA_NOPE:]
    k_rope = jnp.broadcast_to(c_kr[:, :, None, :], (bsz, t, MLA_HEADS, MLA_ROPE))
    k = _rmsnorm(jnp.concatenate([k_nope, k_rope], axis=-1), p['mla_kn_g'])
    if cos is not None:
        k = jnp.concatenate([k[..., :MLA_NOPE], _apply_axial_rope(k[..., MLA_NOPE:], cos, sin)], axis=-1)
    return k, v


def _attend(q, k, v):
    s = jnp.einsum('bqhd,bkhd->bhqk', q, k).astype(jnp.float32) * (MLA_QK ** -0.5)
    pr = jax.nn.softmax(s, axis=-1).astype(v.dtype)
    return jnp.einsum('bhqk,bkhd->bqhd', pr, v)


def _attend_blocked(q, k, v):
    bsz, t, h, d = q.shape
    nb = t // Q_BLOCK
    qb = q.reshape(bsz, nb, Q_BLOCK, h, d).swapaxes(0, 1)
    ob = lax.map(lambda qi: _attend(qi, k, v), qb)
    return ob.swapaxes(0, 1).reshape(bsz, t, h, v.shape[-1])


def _merge_branches(y_a, y_b, y_c, u, p):
    m = (jax.nn.sigmoid(u['g_a']) * (y_a @ p['w_br_a'])
         + jax.nn.sigmoid(u['g_b']) * (y_b @ p['w_br_b'])
         + jax.nn.sigmoid(u['g_c']) * (y_c @ p['w_br_c']))
    return m @ p['w_out']


def _layer(x, ctx, c, c_ctx, p, cos, sin, update_ctx):
    mod_x = jax.nn.silu(c) @ p['w_mod'] + p['b_mod']
    mod_c = jax.nn.silu(c_ctx) @ p['w_mod'] + p['b_mod']
    shift_x, scale_x, gate_x = jnp.split(mod_x[:, None, :], 3, axis=-1)
    shift_c, scale_c, gate_c = jnp.split(mod_c, 3, axis=-1)
    hx = _rmsnorm(x, p['norm_g']) * (1.0 + scale_x) + shift_x
    hc = _rmsnorm(ctx, p['norm_g']) * (1.0 + scale_c) + shift_c
    ux = _split_in(hx @ p['w_in'])
    uc = _split_in(hc @ p['w_in'])

    kc_g, vc_g, laf_c, lab_c = _gla_prepare(uc, p)
    s_f = _gla_final_state(kc_g, vc_g, laf_c)
    s_b = _gla_final_state(jnp.flip(kc_g, 1), jnp.flip(vc_g, 1), jnp.flip(lab_c, 1))
    k_ctx, v_ctx = _mla_kv(uc['c_kv'], uc['c_kr'], p, None, None)

    bsz, t = x.shape[:2]
    y_a = _short_conv_mixer(ux, p['conv_w'])
    kx, vx, laf_x, lab_x = _gla_prepare(ux, p)
    y_b = _gla_output(_gla_bidir(_gla_query(ux), kx, vx, laf_x, lab_x, s_f, s_b), ux['b_z'], p['gla_norm_g'])
    q_lat = _mla_q(ux['c_q'], p, cos, sin)
    k_lat, v_lat = _mla_kv(ux['c_kv'], ux['c_kr'], p, cos, sin)
    o_c = _attend_blocked(q_lat, jnp.concatenate([k_lat, k_ctx], axis=1), jnp.concatenate([v_lat, v_ctx], axis=1))
    y_c = o_c.reshape(bsz, t, MLA_HEADS * MLA_DV) * jax.nn.silu(ux['c_z'])
    x_new = x + gate_x * _merge_branches(y_a, y_b, y_c, ux, p)

    if update_ctx:
        lc = ctx.shape[1]
        zeros = jnp.zeros_like(s_f)
        yc_a = _short_conv_mixer(uc, p['conv_w'])
        yc_b = _gla_output(_gla_bidir(_gla_query(uc), kc_g, vc_g, laf_c, lab_c, zeros, zeros), uc['b_z'], p['gla_norm_g'])
        q_ctx = _mla_q(uc['c_q'], p, None, None)
        yc_c = _attend(q_ctx, k_ctx, v_ctx).reshape(ctx.shape[0], lc, MLA_HEADS * MLA_DV) * jax.nn.silu(uc['c_z'])
        ctx = ctx + gate_c * _merge_branches(yc_a, yc_b, yc_c, uc, p)
    return x_new, ctx


def setup_inputs(seed: int = 0) -> dict:
    key = jax.random.key(seed)
    ks = jax.random.split(key, 24)
    f32 = jnp.float32

    def nrm(k, shape, s):
        return jax.random.normal(k, shape, f32) * s

    def gain(k, shape):
        return 1.0 + 0.02 * jax.random.normal(k, shape, f32)

    L, D = DEPTH, D_MODEL
    return {
        'x': nrm(ks[0], (BATCH, SEQ, D), 1.0),
        'c': nrm(ks[1], (BATCH, D), 1.0),
        'ctx': nrm(ks[2], (BATCH, CTX_LEN, D), 1.0),
        'c_ctx': nrm(ks[3], (D,), 1.0),
        'w_mod': nrm(ks[4], (L, D, 3 * D), 0.5 * D ** -0.5),
        'b_mod': nrm(ks[5], (L, 3 * D), 0.02),
        'norm_g': gain(ks[6], (L, D)),
        'w_in': nrm(ks[7], (L, D, IN_DIM), D ** -0.5),
        'conv_w': nrm(ks[8], (L, 3, CONV_W), 3 ** -0.5),
        'gla_wa_up_f': nrm(ks[9], (L, GLA_RANK, GLA_HEADS * GLA_DK), GLA_RANK ** -0.5),
        'gla_ba_f': nrm(ks[10], (L, GLA_HEADS * GLA_DK), 0.1),
        'gla_wa_up_b': nrm(ks[11], (L, GLA_RANK, GLA_HEADS * GLA_DK), GLA_RANK ** -0.5),
        'gla_ba_b': nrm(ks[12], (L, GLA_HEADS * GLA_DK), 0.1),
        'gla_norm_g': gain(ks[13], (L, GLA_HEADS * GLA_DV)),
        'mla_q_norm_g': gain(ks[14], (L, MLA_Q_RANK)),
        'mla_kv_norm_g': gain(ks[15], (L, MLA_KV_RANK)),
        'mla_wq_up': nrm(ks[16], (L, MLA_Q_RANK, MLA_HEADS * MLA_QK), MLA_Q_RANK ** -0.5),
        'mla_wkv_up': nrm(ks[17], (L, MLA_KV_RANK, MLA_HEADS * (MLA_NOPE + MLA_DV)), MLA_KV_RANK ** -0.5),
        'mla_qn_g': gain(ks[18], (L, MLA_QK)),
        'mla_kn_g': gain(ks[19], (L, MLA_QK)),
        'w_br_a': nrm(ks[20], (L, CONV_W, D), CONV_W ** -0.5),
        'w_br_b': nrm(ks[21], (L, GLA_HEADS * GLA_DV, D), (GLA_HEADS * GLA_DV) ** -0.5),
        'w_br_c': nrm(ks[22], (L, MLA_HEADS * MLA_DV, D), (MLA_HEADS * MLA_DV) ** -0.5),
        'w_out': nrm(ks[23], (L, D, D), D ** -0.5),
    }


def reference(x, c, ctx, c_ctx, w_mod, b_mod, norm_g, w_in, conv_w, gla_wa_up_f, gla_ba_f, gla_wa_up_b,
              gla_ba_b, gla_norm_g, mla_q_norm_g, mla_kv_norm_g, mla_wq_up, mla_wkv_up, mla_qn_g, mla_kn_g,
              w_br_a, w_br_b, w_br_c, w_out):
    cos, sin = _axial_rope_tables(x.shape[1])
    for l in range(DEPTH):
        p = {
            'w_mod': w_mod[l], 'b_mod': b_mod[l], 'norm_g': norm_g[l], 'w_in': w_in[l], 'conv_w': conv_w[l],
            'gla_wa_up_f': gla_wa_up_f[l], 'gla_ba_f': gla_ba_f[l], 'gla_wa_up_b': gla_wa_up_b[l],
            'gla_ba_b': gla_ba_b[l], 'gla_norm_g': gla_norm_g[l], 'mla_q_norm_g': mla_q_norm_g[l],
            'mla_kv_norm_g': mla_kv_norm_g[l], 'mla_wq_up': mla_wq_up[l], 'mla_wkv_up': mla_wkv_up[l],
            'mla_qn_g': mla_qn_g[l], 'mla_kn_g': mla_kn_g[l], 'w_br_a': w_br_a[l], 'w_br_b': w_br_b[l],
            'w_br_c': w_br_c[l], 'w_out': w_out[l],
        }
        x, ctx = _layer(x, ctx, c, c_ctx, p, cos, sin, l < DEPTH - 1)
    return x
```

```cpp
#include <hip/hip_runtime.h>
#include <hip/hip_cooperative_groups.h>
#include <cstdio>
#include <cstdint>
namespace cg = cooperative_groups;
#ifndef GLA_DBG
#define GLA_DBG 0
#endif

#define LAS __attribute__((address_space(3)))
typedef unsigned short bf16_t;
typedef short bf16x8 __attribute__((ext_vector_type(8)));
typedef short s16x4 __attribute__((ext_vector_type(4)));
typedef float f32x4 __attribute__((ext_vector_type(4)));
typedef float f32x16 __attribute__((ext_vector_type(16)));
typedef unsigned u32x4 __attribute__((ext_vector_type(4)));
typedef unsigned u32x2 __attribute__((ext_vector_type(2)));

constexpr int DM = 1024, NB = 4, SEQ = 4096, DEPTH = 4, CTXL = 256;
constexpr int NLAT = NB * SEQ, NCTX = NB * CTXL, NR = NLAT + NCTX;
constexpr int IN_DIM = 11872, LDU = 12032;
constexpr int C_AV = 0, C_AB = 1024, C_AC = 2048, C_AZ = 3072, C_BQ = 4096, C_BK = 4608, C_BV = 5120, C_BZ = 6144, C_BAF = 7168, C_BAB = 7184,
              C_CQ = 7200, C_CKV = 7584, C_CKR = 7712, C_CZ = 7776, C_GA = 8800;
constexpr int LDQ = 1536, LDK = 1536, LDV = 1024;
constexpr float EPS = 1e-6f;
constexpr size_t al256(size_t x) { return (x + 255) / 256 * 256; }
constexpr size_t WS_U = 0;
constexpr size_t WS_WIN = al256(WS_U + (size_t)NR * LDU * 2);
constexpr size_t WS_WQ = al256(WS_WIN + (size_t)LDU * 1024 * 2);
constexpr size_t WS_WKV = al256(WS_WQ + (size_t)1536 * 384 * 2);
constexpr size_t WS_WBR = al256(WS_WKV + (size_t)2048 * 256 * 2);
constexpr size_t WS_WOUT = al256(WS_WBR + (size_t)3 * 1024 * 1024 * 2);
constexpr size_t WS_H = al256(WS_WOUT + (size_t)1024 * 1024 * 2);
constexpr size_t WS_Q = al256(WS_H + (size_t)NR * 1024 * 2);
constexpr size_t WS_K = al256(WS_Q + (size_t)NR * LDQ * 2);
constexpr size_t WS_V = al256(WS_K + (size_t)NR * LDK * 2);
constexpr size_t WS_CTX = al256(WS_V + (size_t)NR * LDV * 2);
constexpr size_t WS_MOD = al256(WS_CTX + (size_t)NCTX * 1024 * 4);
constexpr size_t WS_ROPE = al256(WS_MOD + (size_t)DEPTH * 5 * 3072 * 4);
constexpr size_t WS_QD = al256(WS_ROPE + 64 * 16 * 2 * 4 + 256);
constexpr size_t WS_KET = al256(WS_QD + (size_t)2 * NR * 512 * 2);
constexpr size_t WS_GD = al256(WS_KET + (size_t)2 * NR * 512 * 2);
constexpr size_t WS_BAR = al256(WS_GD + (size_t)2 * 16 * 68 * 128 * 4);
constexpr size_t WS_YA = al256(WS_BAR + 3456 * 4);
constexpr size_t WS_MC = al256(WS_YA + (size_t)NR * 1024 * 2);
constexpr size_t WS_CN = al256(WS_MC + (size_t)3 * 1024 * 1024 * 2);
constexpr size_t WS_END = al256(WS_CN + (size_t)NR * 512 * 2 + 1024);
constexpr size_t WS_YB = WS_QD, WS_YC = WS_KET;
static_assert(WS_END <= 778043392ull, "workspace budget");
constexpr int LDS_BYTES = 147456;

struct Params { const float* in[24]; float* out; unsigned char* ws; };

__device__ __forceinline__ float bf2f(unsigned b) { return __uint_as_float(b << 16); }
__device__ __forceinline__ float bflo(unsigned w) { return __uint_as_float(w << 16); }
__device__ __forceinline__ float bfhi(unsigned w) { return __uint_as_float(w & 0xffff0000u); }
typedef __bf16 bf16x2_t __attribute__((ext_vector_type(2)));
typedef float f32x2_t __attribute__((ext_vector_type(2)));
__device__ __forceinline__ unsigned cvt_pk_bf16(float lo, float hi) { f32x2_t v = {lo, hi}; bf16x2_t b = __builtin_convertvector(v, bf16x2_t); return __builtin_bit_cast(unsigned, b); }
__device__ __forceinline__ bf16_t f2bf(float x) { return (bf16_t)(cvt_pk_bf16(x, 0.f) & 0xffffu); }
__device__ __forceinline__ int otid() { int t = threadIdx.x; asm volatile("" : "+v"(t)); return t; }
__device__ __forceinline__ int obid() { int t = blockIdx.x; asm volatile("" : "+s"(t)); return t; }
__device__ __forceinline__ float sigmf(float x) { return __builtin_amdgcn_rcpf(1.f + __builtin_amdgcn_exp2f(x * -1.4426950408889634f)); }
__device__ __forceinline__ float siluf(float x) { return x * sigmf(x); }
__device__ __forceinline__ float wave_sum(float v) {
#pragma unroll
  for (int m = 32; m >= 1; m >>= 1) v += __shfl_xor(v, m, 64);
  return v;
}
__device__ __forceinline__ void unpack8(u32x4 w, float* f) {
  f[0] = bflo(w[0]); f[1] = bfhi(w[0]); f[2] = bflo(w[1]); f[3] = bfhi(w[1]); f[4] = bflo(w[2]); f[5] = bfhi(w[2]); f[6] = bflo(w[3]); f[7] = bfhi(w[3]);
}
__device__ __forceinline__ u32x4 pack8(const float* f) {
  u32x4 w; w[0] = cvt_pk_bf16(f[0], f[1]); w[1] = cvt_pk_bf16(f[2], f[3]); w[2] = cvt_pk_bf16(f[4], f[5]); w[3] = cvt_pk_bf16(f[6], f[7]); return w;
}

namespace pg8 {
constexpr int BM = 256, BK = 64, HALF = 128, HTB = HALF * BK * 2, STAGE_BYTES = 8 * HTB, NXCD = 8, WGM = 8;
__device__ __forceinline__ int lds_byte(int r, int c) { const int st = (r >> 4) * 2 + (c >> 5), rr = r & 15, cc = c & 31, ob = rr * 64 + cc * 2; return st * 1024 + (ob ^ (((ob >> 9) & 1) << 5)); }
__device__ __forceinline__ void stage_rc(int b, int& R, int& C) { const int st = b / 1024, sb = b % 1024, swz = sb ^ (((sb >> 9) & 1) << 5); R = (st >> 1) * 16 + swz / 64; C = (st & 1) * 32 + (swz % 64) / 2; }
__device__ __forceinline__ int perm32(int rho) { const int n = rho >> 4, i = rho & 15; return 8 * (i >> 2) + 4 * n + (i & 3); }
struct Unit { int pm, pn, z; };

__device__ __forceinline__ bool static_next(int nM, int nN, int G, int c, int i, Unit& u) {
  const int nwg = nM * nN; const long L = (long)i * G + c; if (L >= nwg) return false;
  int wgid = (int)L; { const int q = nwg / NXCD, r = nwg % NXCD, xcd = wgid % NXCD, off = wgid / NXCD; wgid = (xcd < r ? xcd * (q + 1) : r * (q + 1) + (xcd - r) * q) + off; }
  const int nig = WGM * nN, gid = wgid / nig, fm = gid * WGM, gsz = (nM - fm) < WGM ? (nM - fm) : WGM;
  u.pm = fm + ((wgid % nig) % gsz); u.pn = (wgid % nig) / gsz; u.z = 0; return true;
}

template <class Epi, class Sched>
__device__ __forceinline__ void gemm_phase(LAS unsigned char* lds, const int K, const int lda, const int ldb, const Sched& S, const Epi& E) {
  const int tid = otid(), wid = __builtin_amdgcn_readfirstlane(tid >> 6), lane = tid & 63, wr = wid >> 2, wc = wid & 3, fr = lane & 15, fq = lane >> 4;
  const int nt = K / BK;
  unsigned voffA[2], voffB[2];
#pragma unroll
  for (int i = 0; i < 2; ++i) { int R, C; stage_rc(tid * 16 + i * 8192, R, C); const int Rb = (R & ~31) + perm32(R & 31);
    voffA[i] = (unsigned)(R * lda + C) * 2u; voffB[i] = (unsigned)(Rb * ldb + C) * 2u; }
  const size_t kstep = (size_t)(BK * 2);
  const size_t hstepA = (size_t)HALF * lda * 2, hstepB = (size_t)HALF * ldb * 2;
  const unsigned ldsw = (unsigned)wid * 1024u;
  const int aoff = lds_byte(wr * 64 + fr, fq * 8), boff = lds_byte(wc * 32 + fr, fq * 8);
#define PG8_SA(b, h) (((b) * 2 + (h)) * HTB)
#define PG8_SB(b, h) ((4 + (b) * 2 + (h)) * HTB)
#define PG8_STAGE(bufoff, gbase, voff) do { _Pragma("unroll") for (int _i = 0; _i < 2; ++_i) \
    __builtin_amdgcn_global_load_lds((const unsigned*)((const char*)(gbase) + (voff)[_i]), (LAS unsigned*)(lds + (bufoff) + ldsw + _i * 8192), 16, 0, 0); } while (0)
#define PG8_LDA(dst, b, h) do { _Pragma("unroll") for (int m = 0; m < 4; ++m) _Pragma("unroll") for (int k = 0; k < 2; ++k) dst[m][k] = *(const LAS bf16x8*)(lds + PG8_SA(b, h) + aoff + m * 2048 + k * 1024); } while (0)
#define PG8_LDB(dst, b, h) do { _Pragma("unroll") for (int n = 0; n < 2; ++n) _Pragma("unroll") for (int k = 0; k < 2; ++k) dst[n][k] = *(const LAS bf16x8*)(lds + PG8_SB(b, h) + boff + n * 2048 + k * 1024); } while (0)
#define PG8_MMA(ai, bj, At, Bt) do { __builtin_amdgcn_s_setprio(1); _Pragma("unroll") for (int m = 0; m < 4; ++m) _Pragma("unroll") for (int n = 0; n < 2; ++n) _Pragma("unroll") for (int k = 0; k < 2; ++k) \
    acc[ai][bj][m][n] = __builtin_amdgcn_mfma_f32_16x16x32_bf16(Bt[n][k], At[m][k], acc[ai][bj][m][n], 0, 0, 0); __builtin_amdgcn_s_setprio(0); } while (0)
#define PG8_WAIT_V(n) asm volatile("s_waitcnt vmcnt(" #n ")" ::: "memory")
#define PG8_WAIT_L(n) asm volatile("s_waitcnt lgkmcnt(" #n ")" ::: "memory")
#define PG8_BAR __builtin_amdgcn_s_barrier()
#define PG8_SCHED __builtin_amdgcn_sched_barrier(0)
  Unit cur, nxt; int ui = 0;
  if (!S.next(0, cur)) return;
  f32x4 acc[2][2][4][2];
#pragma unroll
  for (int a = 0; a < 2; ++a)
#pragma unroll
    for (int b = 0; b < 2; ++b)
#pragma unroll
      for (int m = 0; m < 4; ++m)
#pragma unroll
        for (int n = 0; n < 2; ++n) acc[a][b][m][n] = (f32x4){0.f, 0.f, 0.f, 0.f};
  bf16x8 At[4][2], B0[2][2], B1[2][2];
  const char* cA = S.aptr(cur); const char* cB = S.bptr(cur);
  PG8_STAGE(PG8_SB(0, 0), cB, voffB); PG8_STAGE(PG8_SA(0, 0), cA, voffA); PG8_STAGE(PG8_SB(0, 1), cB + hstepB, voffB); PG8_STAGE(PG8_SA(0, 1), cA + hstepA, voffA);
  if (wr == 1) PG8_BAR;
  PG8_WAIT_V(4); PG8_BAR;
  PG8_STAGE(PG8_SB(1, 0), cB + kstep, voffB); PG8_STAGE(PG8_SA(1, 0), cA + kstep, voffA); PG8_STAGE(PG8_SB(1, 1), cB + hstepB + kstep, voffB);
  PG8_WAIT_V(6); PG8_BAR;
  for (;;) {
    const bool has_next = S.next(ui + 1, nxt);
    const char* nA = has_next ? S.aptr(nxt) : cA; const char* nB = has_next ? S.bptr(nxt) : cB;
    for (int t = 0; t < nt; t += 2) {
      const bool last = (t == nt - 2);
      const char* a1 = cA + (size_t)(t + 1) * kstep;
      const char* a2 = last ? nA : cA + (size_t)(t + 2) * kstep; const char* b2 = last ? nB : cB + (size_t)(t + 2) * kstep;
      const char* a3 = a2 + kstep; const char* b3 = b2 + kstep;
      PG8_LDB(B0, 0, 0); PG8_SCHED; PG8_LDA(At, 0, 0); PG8_STAGE(PG8_SA(1, 1), a1 + hstepA, voffA);
      PG8_WAIT_L(8); PG8_BAR; PG8_WAIT_L(0); PG8_MMA(0, 0, At, B0); PG8_BAR; PG8_SCHED;
      PG8_LDB(B1, 0, 1); PG8_STAGE(PG8_SB(0, 0), b2, voffB);
      PG8_BAR; PG8_WAIT_L(0); PG8_MMA(0, 1, At, B1); PG8_BAR;
      PG8_LDA(At, 0, 1); PG8_STAGE(PG8_SA(0, 0), a2, voffA);
      PG8_BAR; PG8_WAIT_L(0); PG8_MMA(1, 0, At, B0); PG8_BAR; PG8_SCHED;
      PG8_STAGE(PG8_SB(0, 1), b2 + hstepB, voffB);
      PG8_WAIT_V(6); PG8_BAR; PG8_MMA(1, 1, At, B1); PG8_BAR;
      PG8_LDB(B0, 1, 0); PG8_SCHED; PG8_LDA(At, 1, 0); PG8_STAGE(PG8_SA(0, 1), a2 + hstepA, voffA);
      PG8_WAIT_L(8); PG8_BAR; PG8_WAIT_L(0); PG8_MMA(0, 0, At, B0); PG8_BAR; PG8_SCHED;
      PG8_LDB(B1, 1, 1); PG8_STAGE(PG8_SB(1, 0), b3, voffB);
      PG8_BAR; PG8_WAIT_L(0); PG8_MMA(0, 1, At, B1); PG8_BAR;
      PG8_LDA(At, 1, 1); PG8_STAGE(PG8_SA(1, 0), a3, voffA);
      PG8_BAR; PG8_WAIT_L(0); PG8_MMA(1, 0, At, B0); PG8_BAR; PG8_SCHED;
      PG8_STAGE(PG8_SB(1, 1), b3 + hstepB, voffB);
      PG8_WAIT_V(6); PG8_BAR; PG8_MMA(1, 1, At, B1); PG8_BAR;
    }
    E(acc, cur, wr, wc, fr, fq);
    if (!has_next) break;
#pragma unroll
    for (int a = 0; a < 2; ++a)
#pragma unroll
      for (int b = 0; b < 2; ++b)
#pragma unroll
        for (int m = 0; m < 4; ++m)
#pragma unroll
          for (int n = 0; n < 2; ++n) acc[a][b][m][n] = (f32x4){0.f, 0.f, 0.f, 0.f};
    cur = nxt; cA = nA; cB = nB; ++ui;
  }
  PG8_WAIT_V(0);
  if (wr == 0) PG8_BAR;
  PG8_BAR;
#undef PG8_SA
#undef PG8_SB
#undef PG8_STAGE
#undef PG8_LDA
#undef PG8_LDB
#undef PG8_MMA
#undef PG8_WAIT_V
#undef PG8_WAIT_L
#undef PG8_BAR
#undef PG8_SCHED
}

template <class F> struct EpiRow {
  F f;
  __device__ __forceinline__ void operator()(const f32x4 (&acc)[2][2][4][2], const Unit& u, int wr, int wc, int fr, int fq) const {
    const int row0 = u.pm * BM + wr * 64 + fr, col0 = u.pn * BM + wc * 32 + 8 * fq;
#pragma unroll
    for (int ai = 0; ai < 2; ++ai)
#pragma unroll
      for (int m = 0; m < 4; ++m)
#pragma unroll
        for (int bj = 0; bj < 2; ++bj) f(u, row0 + ai * HALF + m * 16, col0 + bj * HALF, acc[ai][bj][m][0], acc[ai][bj][m][1]);
  }
};
}
using pg8::Unit;

struct SchedSimple {
  const char* A; const char* Bt; int nM, nN, G, c; size_t tstepA, tstepB;
  __device__ __forceinline__ bool next(int i, Unit& u) const { return pg8::static_next(nM, nN, G, c, i, u); }
  __device__ __forceinline__ const char* aptr(const Unit& u) const { return A + (size_t)u.pm * tstepA; }
  __device__ __forceinline__ const char* bptr(const Unit& u) const { return Bt + (size_t)u.pn * tstepB; }
};
struct SchedMerge {
  const char* A0; const char* A1; const char* A2; const char* Bt; int G, c, nctx; size_t tstepA, tstepB;
  __device__ __forceinline__ bool next(int i, Unit& u) const {
    const int nl = c < 256 ? (256 - c + G - 1) / G : 0;
    if (i < 3 * nl) { const int ti = i / 3, z = i - ti * 3, t0 = ti * G + c, tile = (G == 256) ? ((t0 & 7) * 32 + (t0 >> 3)) : t0; u.pm = tile >> 2; u.pn = tile & 3; u.z = z; return true; }
    const int j = (i - 3 * nl) * G + c; if (j >= nctx) return false;
    const int tile = j / 3; u.pm = 64 + (tile >> 2); u.pn = tile & 3; u.z = 4 + (j - tile * 3); return true; }
  __device__ __forceinline__ const char* aptr(const Unit& u) const { const int zz = u.z & 3; return (zz == 0 ? A0 : (zz == 1 ? A1 : A2)) + (size_t)u.pm * tstepA; }
  __device__ __forceinline__ const char* bptr(const Unit& u) const { return Bt + ((size_t)(u.z & 3) * 4 + u.pn) * tstepB; }
};
struct SchedOut {
  const char* M; const char* Mc; const char* Bt; int G, c, nctx; size_t tstep;
  __device__ __forceinline__ bool next(int i, Unit& u) const {
    const int nl = c < 256 ? (256 - c + G - 1) / G : 0;
    if (i < nl) { const int t0 = i * G + c, tile = (G == 256) ? ((t0 & 7) * 32 + (t0 >> 3)) : t0; u.pm = tile >> 2; u.pn = tile & 3; u.z = 0; return true; }
    const int j = (i - nl) * G + c; if (j >= nctx) return false;
    const int tile = j / 3; u.pm = 64 + (tile >> 2); u.pn = tile & 3; u.z = 4 + (j - tile * 3); return true; }
  __device__ __forceinline__ const char* aptr(const Unit& u) const { return u.z < 4 ? M + (size_t)u.pm * tstep : Mc + ((size_t)(u.z & 3) * 4 + (u.pm - 64)) * tstep; }
  __device__ __forceinline__ const char* bptr(const Unit& u) const { return Bt + (size_t)u.pn * tstep; }
};

struct FStoreBf16 { bf16_t* O; int ldc;
  __device__ __forceinline__ void operator()(const Unit&, int row, int col, f32x4 v0, f32x4 v1) const {
    u32x4 w; w[0] = cvt_pk_bf16(v0[0], v0[1]); w[1] = cvt_pk_bf16(v0[2], v0[3]); w[2] = cvt_pk_bf16(v1[0], v1[1]); w[3] = cvt_pk_bf16(v1[2], v1[3]);
    *(u32x4*)(O + (size_t)row * ldc + col) = w; } };
struct FStoreKV { bf16_t* Kb; bf16_t* Vb;
  __device__ __forceinline__ void operator()(const Unit&, int row, int col, f32x4 v0, f32x4 v1) const {
    u32x4 w; w[0] = cvt_pk_bf16(v0[0], v0[1]); w[1] = cvt_pk_bf16(v0[2], v0[3]); w[2] = cvt_pk_bf16(v1[0], v1[1]); w[3] = cvt_pk_bf16(v1[2], v1[3]);
    const int h = col >> 8, j = col & 255;
    bf16_t* dst = (j < 128) ? (Kb + (size_t)row * LDK + h * 192 + j) : (Vb + (size_t)row * LDV + h * 128 + (j - 128));
    *(u32x4*)dst = w; } };
struct FMerge { const bf16_t* U; bf16_t* Mo; bf16_t* Mc;
  __device__ __forceinline__ void operator()(const Unit& u, int row, int col, f32x4 v0, f32x4 v1) const {
    const int zz = u.z & 3;
    const u32x4 gw = *(const u32x4*)(U + (size_t)row * LDU + C_GA + zz * 1024 + col);
    float g[8]; unpack8(gw, g);
    float r[8];
#pragma unroll
    for (int j = 0; j < 4; ++j) { r[j] = sigmf(g[j]) * v0[j]; r[4 + j] = sigmf(g[4 + j]) * v1[j]; }
    if (u.z >= 4) { *(u32x4*)(Mc + ((size_t)zz * 1024 + (row - NLAT)) * 1024 + col) = pack8(r); return; }
    bf16_t* mp = Mo + (size_t)row * 1024 + col;
    if (u.z != 0) { const u32x4 ow = *(const u32x4*)mp; float o[8]; unpack8(ow, o);
#pragma unroll
      for (int j = 0; j < 8; ++j) r[j] += o[j]; }
    *(u32x4*)mp = pack8(r); } };
struct FOut { const float* xlat; float* olat; float* pctx; const float* mod; int lidx; bool dry;
  __device__ __forceinline__ void operator()(const Unit& u, int row, int col, f32x4 v0, f32x4 v1) const {
    if (row < NLAT) {
      const float* src = xlat + (size_t)row * 1024 + col; float* dst = olat + (size_t)row * 1024 + col;
      const float* gp = mod + (row >> 12) * 3072 + 2048 + col;
      const f32x4 g0 = *(const f32x4*)gp, g1 = *(const f32x4*)(gp + 4), x0 = *(const f32x4*)src, x1 = *(const f32x4*)(src + 4);
      if (!dry) { *(f32x4*)dst = x0 + g0 * v0; *(f32x4*)(dst + 4) = x1 + g1 * v1; }
    } else {
      float* dst = pctx + ((size_t)(u.z & 3) * 1024 + (row - NLAT)) * 1024 + col; const float* gp = mod + 4 * 3072 + 2048 + col;
      const f32x4 g0 = *(const f32x4*)gp, g1 = *(const f32x4*)(gp + 4);
      *(f32x4*)dst = g0 * v0; *(f32x4*)(dst + 4) = g1 * v1;
    } } };

__device__ __forceinline__ void phase_mod(const Params& p, unsigned char* lds) {
  float* sc = (float*)lds;
  const float* cin = p.in[1]; const float* cctx = p.in[3]; const float* wmod = p.in[4]; const float* bmod = p.in[5];
  float* mod = (float*)(p.ws + WS_MOD);
  const int tid = otid();
#ifdef LDS_PROBE
  { unsigned* fl = (unsigned*)(p.ws + WS_ROPE + 8192); unsigned bad = 0;
    for (int rep = 0; rep < 3; ++rep) { const int off = rep == 0 ? 61440 : (rep == 1 ? 100000 : 145408);
      __syncthreads();
      *(unsigned*)(lds + off + tid * 4) = 0x12340000u + tid * 7 + rep;
      __syncthreads();
      const int o = (tid + 77) & 511;
      if (*(unsigned*)(lds + off + o * 4) != 0x12340000u + o * 7 + rep) bad |= (1u << rep);
    }
    if (bad) atomicOr(fl, bad); }
#endif
  for (int it = blockIdx.x; it < DEPTH * 12 * 16; it += gridDim.x) {
    const int kb = it & 15, nb = (it >> 4) % 12, l = it / 192;
    __syncthreads();
    if (tid < 320) { const int bb = tid >> 6, kk = tid & 63; const float c = bb < 4 ? cin[bb * 1024 + kb * 64 + kk] : cctx[kb * 64 + kk]; sc[tid] = siluf(c); }
    __syncthreads();
    const int n = nb * 256 + (tid & 255), kh = tid >> 8;
    const float* w = wmod + ((size_t)l * 1024 + kb * 64 + kh * 32) * 3072 + n;
    float a0 = 0, a1 = 0, a2 = 0, a3 = 0, a4 = 0;
#pragma unroll 8
    for (int kk = 0; kk < 32; ++kk) { const float wv = w[(size_t)kk * 3072]; const int ki = kh * 32 + kk;
      a0 += sc[ki] * wv; a1 += sc[64 + ki] * wv; a2 += sc[128 + ki] * wv; a3 += sc[192 + ki] * wv; a4 += sc[256 + ki] * wv; }
    if (kb == 0 && kh == 0) { const float bv = bmod[l * 3072 + n]; a0 += bv; a1 += bv; a2 += bv; a3 += bv; a4 += bv; }
    float* m = (float*)(p.ws + WS_K) + (size_t)(kb * 2 + kh) * (DEPTH * 5 * 3072) + (size_t)l * 5 * 3072 + n;
    m[0] = a0; m[3072] = a1; m[2 * 3072] = a2; m[3 * 3072] = a3; m[4 * 3072] = a4;
  }
  if (blockIdx.x == gridDim.x - 1) {
    float* rope = (float*)(p.ws + WS_ROPE);
    for (int i = tid; i < 1024; i += 512) { const int pos = i >> 4, fi = i & 15;
      const float f = exp2f(-(float)fi * (13.287712379549449f / 16.f));
      const float ang = (float)pos * f; const float rev = __builtin_amdgcn_fractf(ang * 0.15915494309189535f);
      rope[2 * i] = __builtin_amdgcn_cosf(rev); rope[2 * i + 1] = __builtin_amdgcn_sinf(rev); }
  }
}

__device__ __forceinline__ void transpose_tile(const float* src, int K, int N, bf16_t* dst, int Kpad, int n0, int k0, float* tile, int tid) {
  __syncthreads();
#pragma unroll
  for (int hh = 0; hh < 2; ++hh) { const int kl = (tid >> 4) + hh * 32, nl = (tid & 15) * 4; const int k = k0 + kl, n = n0 + nl;
    f32x4 v = {0.f, 0.f, 0.f, 0.f};
    if (k < K && n < N) v = *(const f32x4*)(src + (size_t)k * N + n);
    float* t = tile + kl * 65 + nl; t[0] = v[0]; t[1] = v[1]; t[2] = v[2]; t[3] = v[3]; }
  __syncthreads();
  const int nl = tid >> 3, kl = (tid & 7) * 8; float f[8];
#pragma unroll
  for (int j = 0; j < 8; ++j) f[j] = tile[(kl + j) * 65 + nl];
  *(u32x4*)(dst + (size_t)(n0 + nl) * Kpad + k0 + kl) = pack8(f);
}
__device__ __forceinline__ void convert_range(const Params& p, int l, unsigned char* lds, int lo, int hi, int widx, int wcount) {
  float* tile = (float*)lds; const int tid0 = otid();
  for (int it = lo + widx; it < hi; it += wcount) {
    const float* src; bf16_t* dst; int K, N, Kpad, nkt, t;
    if (it < 3008) { t = it; src = p.in[7] + (size_t)l * 1024 * IN_DIM; K = 1024; N = IN_DIM; Kpad = 1024; nkt = 16; dst = (bf16_t*)(p.ws + WS_WIN); }
    else if (it < 3152) { t = it - 3008; src = p.in[16] + (size_t)l * 384 * 1536; K = 384; N = 1536; Kpad = 384; nkt = 6; dst = (bf16_t*)(p.ws + WS_WQ); }
    else if (it < 3280) { t = it - 3152; src = p.in[17] + (size_t)l * 128 * 2048; K = 128; N = 2048; Kpad = 256; nkt = 4; dst = (bf16_t*)(p.ws + WS_WKV); }
    else if (it < 4048) { t = it - 3280; const int br = t >> 8; t &= 255; src = p.in[20 + br] + (size_t)l * 1024 * 1024; K = 1024; N = 1024; Kpad = 1024; nkt = 16; dst = (bf16_t*)(p.ws + WS_WBR) + (size_t)br * 1024 * 1024; }
    else { t = it - 4048; src = p.in[23] + (size_t)l * 1024 * 1024; K = 1024; N = 1024; Kpad = 1024; nkt = 16; dst = (bf16_t*)(p.ws + WS_WOUT); }
    const int kt = t % nkt, ntile = t / nkt;
    transpose_tile(src, K, N, dst, Kpad, ntile * 64, kt * 64, tile, tid0);
  }
}
__device__ __forceinline__ void phase_norm_convert(const Params& p, int l, unsigned char* lds) {
  convert_range(p, l, lds, (l == 0 || gridDim.x <= 48) ? 0 : 4048, 4304, blockIdx.x, gridDim.x);
  const int tid0 = otid();
  const int wid = tid0 >> 6, lane = tid0 & 63;
  const float* xlat = l == 0 ? p.in[0] : p.out; const float* xctx = l == 0 ? p.in[2] : (const float*)(p.ws + WS_CTX);
  const float* ng = p.in[6] + l * 1024; const float* mod = (const float*)(p.ws + WS_MOD) + (size_t)l * 5 * 3072;
  bf16_t* H = (bf16_t*)(p.ws + WS_H);
  for (int r = blockIdx.x * 8 + wid; r < NR; r += gridDim.x * 8) {
    const float* xr = r < NLAT ? xlat + (size_t)r * 1024 : xctx + (size_t)(r - NLAT) * 1024; const int bb = r < NLAT ? (r >> 12) : 4;
    f32x4 v[4]; float ss = 0.f;
#pragma unroll
    for (int i = 0; i < 4; ++i) { v[i] = *(const f32x4*)(xr + i * 256 + lane * 4); ss += v[i][0] * v[i][0] + v[i][1] * v[i][1] + v[i][2] * v[i][2] + v[i][3] * v[i][3]; }
    if (r >= NLAT) {
      if (l > 0) { const float* pc = (const float*)(p.ws + WS_Q) + (size_t)(r - NLAT) * 1024;
#pragma unroll
        for (int i = 0; i < 4; ++i) { const int cc = i * 256 + lane * 4;
          v[i] = ((v[i] + *(const f32x4*)(pc + cc)) + *(const f32x4*)(pc + (size_t)1024 * 1024 + cc)) + *(const f32x4*)(pc + (size_t)2 * 1024 * 1024 + cc); }
        ss = 0.f;
#pragma unroll
        for (int i = 0; i < 4; ++i) ss += v[i][0] * v[i][0] + v[i][1] * v[i][1] + v[i][2] * v[i][2] + v[i][3] * v[i][3]; }
#pragma unroll
      for (int i = 0; i < 4; ++i) *(f32x4*)((float*)(p.ws + WS_CTX) + (size_t)(r - NLAT) * 1024 + i * 256 + lane * 4) = v[i]; }
    ss = wave_sum(ss); const float rstd = rsqrtf(ss * (1.f / 1024.f) + EPS);
#pragma unroll
    for (int i = 0; i < 4; ++i) { const int c = i * 256 + lane * 4;
      const f32x4 g = *(const f32x4*)(ng + c), sh = *(const f32x4*)(mod + bb * 3072 + c), scl = *(const f32x4*)(mod + bb * 3072 + 1024 + c);
      f32x4 y = v[i] * rstd * g; y = y * (scl + 1.f) + sh;
      u32x2 w; w[0] = cvt_pk_bf16(y[0], y[1]); w[1] = cvt_pk_bf16(y[2], y[3]);
      *(u32x2*)(H + (size_t)r * 1024 + c) = w; }
  }
}

__device__ __forceinline__ void phase_prep(const Params& p, int l, bool dry = false) {
  const int tid0 = otid(); const int wid = tid0 >> 6, lane = tid0 & 63;
  bf16_t* U = (bf16_t*)(p.ws + WS_U); bf16_t* YA = (bf16_t*)(p.ws + WS_YA);
  const float* cw = p.in[8] + (size_t)l * 3 * 1024; const float* gq = p.in[14] + l * 384; const float* gkv = p.in[15] + l * 128;
  const int c0 = lane * 16;
  float w0[16], w1[16], w2[16];
#pragma unroll
  for (int j = 0; j < 16; ++j) { w0[j] = cw[c0 + j]; w1[j] = cw[1024 + c0 + j]; w2[j] = cw[2048 + c0 + j]; }
  const bool isq = lane < 48; const int cn = isq ? C_CQ + lane * 8 : C_CKV + (lane - 48) * 8;
  float gn[8];
#pragma unroll
  for (int j = 0; j < 8; ++j) gn[j] = isq ? gq[lane * 8 + j] : gkv[(lane - 48) * 8 + j];
  for (int r = blockIdx.x * 8 + wid; r < NR; r += gridDim.x * 8) {
    const int spos = r < NLAT ? (r & 4095) : ((r - NLAT) & 255), slen = r < NLAT ? 4096 : 256;
    const bool hp = spos > 0, hn = spos < slen - 1;
    bf16_t* ur = U + (size_t)r * LDU; const bf16_t* up = hp ? ur - LDU : ur; const bf16_t* un = hn ? ur + LDU : ur;
    const float fp = hp ? 1.f : 0.f, fn = hn ? 1.f : 0.f;
    const u32x4 lav0 = *(const u32x4*)(ur + C_AV + c0), lav1 = *(const u32x4*)(ur + C_AV + c0 + 8), lac0 = *(const u32x4*)(ur + C_AC + c0), lac1 = *(const u32x4*)(ur + C_AC + c0 + 8);
    const u32x4 pav0 = *(const u32x4*)(up + C_AV + c0), pav1 = *(const u32x4*)(up + C_AV + c0 + 8), pac0 = *(const u32x4*)(up + C_AC + c0), pac1 = *(const u32x4*)(up + C_AC + c0 + 8);
    const u32x4 nav0 = *(const u32x4*)(un + C_AV + c0), nav1 = *(const u32x4*)(un + C_AV + c0 + 8), nac0 = *(const u32x4*)(un + C_AC + c0), nac1 = *(const u32x4*)(un + C_AC + c0 + 8);
    const u32x4 lab0 = *(const u32x4*)(ur + C_AB + c0), lab1 = *(const u32x4*)(ur + C_AB + c0 + 8), laz0 = *(const u32x4*)(ur + C_AZ + c0), laz1 = *(const u32x4*)(ur + C_AZ + c0 + 8);
    const u32x4 lcn = *(const u32x4*)(ur + cn);
    float a[16], cc[16], y[16], t0[16], t1[16];
    unpack8(lav0, a); unpack8(lav1, a + 8); unpack8(lac0, cc); unpack8(lac1, cc + 8);
#pragma unroll
    for (int j = 0; j < 16; ++j) y[j] = w1[j] * a[j] * cc[j];
    unpack8(pav0, t0); unpack8(pav1, t0 + 8); unpack8(pac0, t1); unpack8(pac1, t1 + 8);
#pragma unroll
    for (int j = 0; j < 16; ++j) y[j] += fp * w0[j] * t0[j] * t1[j];
    unpack8(nav0, t0); unpack8(nav1, t0 + 8); unpack8(nac0, t1); unpack8(nac1, t1 + 8);
#pragma unroll
    for (int j = 0; j < 16; ++j) y[j] += fn * w2[j] * t0[j] * t1[j];
    unpack8(lab0, t0); unpack8(lab1, t0 + 8); unpack8(laz0, t1); unpack8(laz1, t1 + 8);
#pragma unroll
    for (int j = 0; j < 16; ++j) y[j] = t0[j] * y[j] * siluf(t1[j]);
    *(u32x4*)(YA + (size_t)r * 1024 + c0) = pack8(y); *(u32x4*)(YA + (size_t)r * 1024 + c0 + 8) = pack8(y + 8);
    { float x[8]; unpack8(lcn, x);
      float ss = 0.f;
#pragma unroll
      for (int j = 0; j < 8; ++j) ss += x[j] * x[j];
      const float sq = wave_sum(isq ? ss : 0.f), sk = wave_sum(isq ? 0.f : ss);
      const float rstd = isq ? rsqrtf(sq * (1.f / 384.f) + EPS) : rsqrtf(sk * (1.f / 128.f) + EPS);
#pragma unroll
      for (int j = 0; j < 8; ++j) x[j] = x[j] * rstd * gn[j];
      *(u32x4*)((bf16_t*)(p.ws + WS_CN) + (size_t)r * 512 + (isq ? lane * 8 : 384 + (lane - 48) * 8)) = pack8(x); }
  }
}

__device__ __forceinline__ int gla_row(int b, int dir, int n, int i) {
  const int tau = n * 64 + i;
  if (n < 4) { const int j = dir ? 255 - tau : tau; return NLAT + b * 256 + j; }
  const int tp = tau - 256; const int t = dir ? 4095 - tp : tp; return b * 4096 + t;
}
__device__ __forceinline__ void phase_gla_intra(const Params& p, int l, unsigned char* lds, int c, int G) {
  const int tid = otid(), wid = tid >> 6, lane = tid & 63, fr = lane & 15, fq = lane >> 4;
  const int h = c & 3;
  bf16_t* U = (bf16_t*)(p.ws + WS_U);
  float* Wl = (float*)lds;
  float* Bl = Wl + 4096;
  unsigned char* QdF = lds + 17408;
  unsigned char* KiF = QdF + 17408; unsigned char* QdB = KiF + 17408; unsigned char* KiB = QdB + 17408;
  unsigned char* Vt = KiB + 17408;
  unsigned char* Att = Vt + 36864;
  const int cq = C_BQ + h * 128 + wid * 16, ck = C_BK + h * 128 + wid * 16, cv = C_BV + h * 256 + wid * 32;
  const int qstep = G >> 2;
  int qi = c >> 2;
  u32x4 q0, q1, k0, k1, a0, a1, e0, e1, v0, v1, v2, v3;
#define G1_ROW(Q, i) (((Q) % 68) < 4 ? NLAT + ((Q) / 68) * 256 + ((Q) % 68) * 64 + (i) : ((Q) / 68) * 4096 + (((Q) % 68) - 4) * 64 + (i))
#define G1_LOAD(Q) do { const bf16_t* ur = U + (size_t)G1_ROW(Q, lane) * LDU; \
    q0 = *(const u32x4*)(ur + cq); q1 = *(const u32x4*)(ur + cq + 8); k0 = *(const u32x4*)(ur + ck); k1 = *(const u32x4*)(ur + ck + 8); \
    a0 = *(const u32x4*)(ur + C_BAF); a1 = *(const u32x4*)(ur + C_BAF + 8); e0 = *(const u32x4*)(ur + C_BAB); e1 = *(const u32x4*)(ur + C_BAB + 8); \
    v0 = *(const u32x4*)(ur + cv); v1 = *(const u32x4*)(ur + cv + 8); v2 = *(const u32x4*)(ur + cv + 16); v3 = *(const u32x4*)(ur + cv + 24); } while (0)
  if (qi < 272) G1_LOAD(qi);
  __syncthreads();
  for (int i = tid; i < 4096; i += 512) { const int d_ = i >> 11, j_ = i & 2047; Wl[i] = (p.in[d_ ? 11 : 9] + (size_t)l * 16 * 512 + h * 128)[(j_ >> 7) * 512 + (j_ & 127)]; }
  if (tid < 256) Bl[tid] = (p.in[(tid >> 7) ? 12 : 10] + l * 512 + h * 128)[tid & 127];
  for (; qi < 272; qi += qstep) {
  const int b = qi / 68, pc = qi - b * 68, bh = b * 4 + h;
  const int row = G1_ROW(qi, lane);
  const int nF = pc, nB = pc < 4 ? 3 - pc : 71 - pc;
  __syncthreads();
  {
#define VTW(V, base) do { _Pragma("unroll") for (int ee = 0; ee < 4; ++ee) { \
      *(bf16_t*)(Vt + (wid * 32 + (base) + 2 * ee) * 144 + lane * 2) = (bf16_t)((V)[ee] & 0xffffu); *(bf16_t*)(Vt + (wid * 32 + (base) + 2 * ee + 1) * 144 + lane * 2) = (bf16_t)((V)[ee] >> 16); } } while (0)
    VTW(v0, 0); VTW(v1, 8); VTW(v2, 16); VTW(v3, 24);
#undef VTW
    float qf[16], kf[16];
    unpack8(q0, qf); unpack8(q1, qf + 8); unpack8(k0, kf); unpack8(k1, kf + 8);
#pragma unroll 1
    for (int dir = 0; dir < 2; ++dir) {
      float av[16], la[16];
      if (dir == 0) { unpack8(a0, av); unpack8(a1, av + 8); } else { unpack8(e0, av); unpack8(e1, av + 8); }
      const float* Wd = Wl + dir * 2048;
#pragma unroll
      for (int dd = 0; dd < 16; ++dd) la[dd] = Bl[dir * 128 + wid * 16 + dd];
#pragma unroll
      for (int r = 0; r < 16; ++r) {
        const f32x4 w0 = *(const f32x4*)(Wd + r * 128 + wid * 16), w1 = *(const f32x4*)(Wd + r * 128 + wid * 16 + 4), w2 = *(const f32x4*)(Wd + r * 128 + wid * 16 + 8), w3 = *(const f32x4*)(Wd + r * 128 + wid * 16 + 12);
#pragma unroll
        for (int j = 0; j < 4; ++j) { la[j] += av[r] * w0[j]; la[4 + j] += av[r] * w1[j]; la[8 + j] += av[r] * w2[j]; la[12 + j] += av[r] * w3[j]; }
      }
#pragma unroll
      for (int dd = 0; dd < 16; ++dd) { const float z = la[dd]; la[dd] = (fminf(z, 0.f) - __logf(1.f + __expf(-fabsf(z)))) * 0.0625f; }
      if (dir == 0) {
#pragma unroll
        for (int off = 1; off < 64; off <<= 1) {
#pragma unroll
          for (int dd = 0; dd < 16; ++dd) { const float t = __shfl_up(la[dd], off, 64); if (lane >= off) la[dd] += t; }
        }
      } else {
#pragma unroll
        for (int off = 1; off < 64; off <<= 1) {
#pragma unroll
          for (int dd = 0; dd < 16; ++dd) { const float t = __shfl_down(la[dd], off, 64); if (lane + off < 64) la[dd] += t; }
        }
      }
      const int nv = dir ? nB : nF, jv = dir ? 63 - lane : lane;
      bf16_t* ket = (bf16_t*)(p.ws + WS_KET) + ((size_t)((dir * 16 + bh) * 68 + nv)) * 8192 + (size_t)(wid * 16) * 64 + jv;
      float* gd = (float*)(p.ws + WS_GD) + ((size_t)((dir * 16 + bh) * 68 + nv)) * 128 + wid * 16;
      float qd[16], ki[16];
#pragma unroll
      for (int dd = 0; dd < 16; ++dd) {
        const float bl = __shfl(la[dd], dir ? 0 : 63, 64);
        qd[dd] = qf[dd] * 0.08838834764831845f * __expf(la[dd]);
        ki[dd] = kf[dd] * __expf(-la[dd]);
        ket[dd * 64] = f2bf(kf[dd] * __expf(bl - la[dd]));
        if (lane == dd) gd[dd] = __expf(bl);
      }
      unsigned char* Qd = dir ? QdB : QdF; unsigned char* Ki = dir ? KiB : KiF;
      const u32x4 qa = pack8(qd), qb = pack8(qd + 8);
      *(u32x4*)(Qd + lane * 272 + wid * 32) = qa; *(u32x4*)(Qd + lane * 272 + wid * 32 + 16) = qb;
      bf16_t* qdg = (bf16_t*)(p.ws + WS_QD) + ((size_t)dir * NR + row) * 512 + h * 128 + wid * 16;
      *(u32x4*)qdg = qa; *(u32x4*)(qdg + 8) = qb;
      *(u32x4*)(Ki + lane * 272 + wid * 32) = pack8(ki); *(u32x4*)(Ki + lane * 272 + wid * 32 + 16) = pack8(ki + 8);
    }
  }
  if (qi + qstep < 272) G1_LOAD(qi + qstep);
  __syncthreads();
  {
    const int ti = wid >> 1, tj0 = (wid & 1) * 2;
    f32x4 c0 = {0.f, 0.f, 0.f, 0.f}, c1 = {0.f, 0.f, 0.f, 0.f}, d0 = {0.f, 0.f, 0.f, 0.f}, d1 = {0.f, 0.f, 0.f, 0.f};
#pragma unroll
    for (int ks = 0; ks < 4; ++ks) {
      const int ko = (ks * 32 + 8 * fq) * 2;
      const bf16x8 A = *(const bf16x8*)(QdF + (16 * ti + fr) * 272 + ko);
      const bf16x8 B0 = *(const bf16x8*)(KiF + (16 * tj0 + fr) * 272 + ko), B1 = *(const bf16x8*)(KiF + (16 * (tj0 + 1) + fr) * 272 + ko);
      c0 = __builtin_amdgcn_mfma_f32_16x16x32_bf16(A, B0, c0, 0, 0, 0);
      c1 = __builtin_amdgcn_mfma_f32_16x16x32_bf16(A, B1, c1, 0, 0, 0);
      const bf16x8 A2 = *(const bf16x8*)(QdB + (16 * ti + fr) * 272 + ko);
      const bf16x8 E0 = *(const bf16x8*)(KiB + (16 * tj0 + fr) * 272 + ko), E1 = *(const bf16x8*)(KiB + (16 * (tj0 + 1) + fr) * 272 + ko);
      d0 = __builtin_amdgcn_mfma_f32_16x16x32_bf16(A2, E0, d0, 0, 0, 0);
      d1 = __builtin_amdgcn_mfma_f32_16x16x32_bf16(A2, E1, d1, 0, 0, 0);
    }
#pragma unroll
    for (int r = 0; r < 4; ++r) { const int i = 16 * ti + 4 * fq + r, j0 = 16 * tj0 + fr, j1 = j0 + 16;
      *(bf16_t*)(Att + i * 144 + j0 * 2) = f2bf((j0 <= i ? c0[r] : 0.f) + (j0 >= i ? d0[r] : 0.f));
      *(bf16_t*)(Att + i * 144 + j1 * 2) = f2bf((j1 <= i ? c1[r] : 0.f) + (j1 >= i ? d1[r] : 0.f)); }
  }
  __syncthreads();
  {
    bf16_t* Ho = (bf16_t*)(p.ws + WS_H);
    const int ti = wid >> 1, te0 = (wid & 1) * 8;
    const bf16x8 A0 = *(const bf16x8*)(Att + (16 * ti + fr) * 144 + (8 * fq) * 2), A1 = *(const bf16x8*)(Att + (16 * ti + fr) * 144 + (32 + 8 * fq) * 2);
#pragma unroll
    for (int t = 0; t < 8; ++t) {
      const bf16x8 B0 = *(const bf16x8*)(Vt + (16 * (te0 + t) + fr) * 144 + (8 * fq) * 2), B1 = *(const bf16x8*)(Vt + (16 * (te0 + t) + fr) * 144 + (32 + 8 * fq) * 2);
      f32x4 o = {0.f, 0.f, 0.f, 0.f};
      o = __builtin_amdgcn_mfma_f32_16x16x32_bf16(A0, B0, o, 0, 0, 0);
      o = __builtin_amdgcn_mfma_f32_16x16x32_bf16(A1, B1, o, 0, 0, 0);
#pragma unroll
      for (int r = 0; r < 4; ++r) Ho[(size_t)G1_ROW(qi, 16 * ti + 4 * fq + r) * 1024 + h * 256 + 16 * (te0 + t) + fr] = f2bf(o[r]);
    }
  }
  }
#undef G1_LOAD
#undef G1_ROW
}

__device__ __forceinline__ void phase_gla_inter(const Params& p, int l, unsigned char* lds, int item) {
  const int tid = otid(), wid = tid >> 6, lane = tid & 63, fr = lane & 15, fq = lane >> 4;
  const int slot_ = item >> 3, comb_ = (item & 7) * 4 + (slot_ >> 3);
  const int vs = slot_ & 7, bh = comb_ & 15, dir = comb_ >> 4, h = bh & 3, b = bh >> 2;
  bf16_t* U = (bf16_t*)(p.ws + WS_U);
  unsigned char* St = lds + 2 * 40960;
  const bf16_t* QD = (const bf16_t*)(p.ws + WS_QD) + (size_t)dir * NR * 512 + h * 128;
  const bf16_t* KET = (const bf16_t*)(p.ws + WS_KET) + (size_t)((dir * 16 + bh) * 68) * 8192;
  const float* GD = (const float*)(p.ws + WS_GD) + (size_t)((dir * 16 + bh) * 68) * 128;
  const int cv = C_BV + h * 256 + vs * 32, co = (dir ? C_BQ : C_AC) + h * 256 + vs * 32;
  __syncthreads();
  for (int i = tid; i < 2 * 8704 / 4; i += 512) ((unsigned*)St)[i] = 0u;
  f32x4 S[2];
  S[0] = (f32x4){0.f, 0.f, 0.f, 0.f}; S[1] = S[0];
  struct G2Regs { u32x4 q0, q1, k0, k1, vv; float gg; };
  const int qi = tid >> 3, qp = (tid & 7) * 8;
  const int kd = tid >> 2, kp = (tid & 3) * 8;
  const int vj = tid >> 2, ve = (tid & 3) * 8;
#define G2_LOAD(R, n) do { const bf16_t* qr_ = QD + (size_t)gla_row(b, dir, (n), qi) * 512; R.q0 = *(const u32x4*)(qr_ + qp); R.q1 = *(const u32x4*)(qr_ + 64 + qp); \
    const bf16_t* kr_ = KET + (size_t)(n) * 8192 + kd * 64; R.k0 = *(const u32x4*)(kr_ + kp); R.k1 = *(const u32x4*)(kr_ + 32 + kp); \
    if (tid < 256) R.vv = *(const u32x4*)(U + (size_t)gla_row(b, dir, (n), vj) * LDU + cv + ve); \
    if (tid < 128) R.gg = GD[(size_t)(n) * 128 + tid]; } while (0)
  G2Regs RA, RB;
  G2_LOAD(RA, 0); G2_LOAD(RB, 1);
  auto step = [&](G2Regs& R, const int n, const int cb) __attribute__((always_inline)) {
    unsigned char* Qd = lds + cb * 40960; unsigned char* Ket = Qd + 17408; unsigned char* Vt = Ket + 18432; float* Gd = (float*)(Vt + 4608);
    unsigned char* Sc = St + cb * 8704; unsigned char* Sn = St + (cb ^ 1) * 8704;
    *(u32x4*)(Qd + qi * 272 + qp * 2) = R.q0; *(u32x4*)(Qd + qi * 272 + 128 + qp * 2) = R.q1;
    *(u32x4*)(Ket + kd * 144 + kp * 2) = R.k0; *(u32x4*)(Ket + kd * 144 + 64 + kp * 2) = R.k1;
    if (tid < 256) {
#pragma unroll
      for (int ee = 0; ee < 4; ++ee) { *(bf16_t*)(Vt + (ve + 2 * ee) * 144 + vj * 2) = (bf16_t)(R.vv[ee] & 0xffffu); *(bf16_t*)(Vt + (ve + 2 * ee + 1) * 144 + vj * 2) = (bf16_t)(R.vv[ee] >> 16); }
    }
    if (tid < 128) Gd[tid] = R.gg;
    if (n + 2 < 68) G2_LOAD(R, n + 2);
    __syncthreads();
    {
      const int ti = wid >> 1, te = wid & 1;
      f32x4 o = {0.f, 0.f, 0.f, 0.f};
#pragma unroll
      for (int ks = 0; ks < 4; ++ks) {
        const bf16x8 A = *(const bf16x8*)(Qd + (16 * ti + fr) * 272 + (ks * 32 + 8 * fq) * 2);
        const bf16x8 Bs = *(const bf16x8*)(Sc + (16 * te + fr) * 272 + (ks * 32 + 8 * fq) * 2);
        o = __builtin_amdgcn_mfma_f32_16x16x32_bf16(A, Bs, o, 0, 0, 0);
      }
#pragma unroll
      for (int r = 0; r < 4; ++r) U[(size_t)gla_row(b, dir, n, 16 * ti + 4 * fq + r) * LDU + co + 16 * te + fr] = f2bf(o[r]);
      const f32x4 gv = *(const f32x4*)(Gd + wid * 16 + 4 * fq);
      S[0] = S[0] * gv; S[1] = S[1] * gv;
#pragma unroll
      for (int ks = 0; ks < 2; ++ks) {
        const bf16x8 A = *(const bf16x8*)(Ket + (16 * wid + fr) * 144 + (ks * 32 + 8 * fq) * 2);
        const bf16x8 B0 = *(const bf16x8*)(Vt + fr * 144 + (ks * 32 + 8 * fq) * 2), B1 = *(const bf16x8*)(Vt + (16 + fr) * 144 + (ks * 32 + 8 * fq) * 2);
        S[0] = __builtin_amdgcn_mfma_f32_16x16x32_bf16(A, B0, S[0], 0, 0, 0);
        S[1] = __builtin_amdgcn_mfma_f32_16x16x32_bf16(A, B1, S[1], 0, 0, 0);
      }
#pragma unroll
      for (int te2 = 0; te2 < 2; ++te2) { u32x2 w; w[0] = cvt_pk_bf16(S[te2][0], S[te2][1]); w[1] = cvt_pk_bf16(S[te2][2], S[te2][3]);
        *(u32x2*)(Sn + (16 * te2 + fr) * 272 + (16 * wid + 4 * fq) * 2) = w; }
    }
  };
  for (int n = 0; n < 68; n += 2) { step(RA, n, 0); step(RB, n + 1, 1); }
#undef G2_LOAD
  __syncthreads();
}

__device__ __forceinline__ void phase_qknorm_yb(const Params& p, int l, bool dry = false) {
  const int tid0 = otid(); const int wid = tid0 >> 6, lane = tid0 & 63;
  bf16_t* U = (bf16_t*)(p.ws + WS_U); bf16_t* Kb = (bf16_t*)(p.ws + WS_K); bf16_t* YB = (bf16_t*)(p.ws + WS_YB);
  const float* rope = (const float*)(p.ws + WS_ROPE);
  const float* kg = p.in[19] + l * 192; const float* gng = p.in[13] + l * 1024;
  const int hh = lane >> 3, s8 = lane & 7;
  const int c = lane * 16;
  float kgn[16], kgr[8], gg[16];
#pragma unroll
  for (int j = 0; j < 16; ++j) { kgn[j] = kg[s8 * 16 + j]; gg[j] = gng[c + j]; }
#pragma unroll
  for (int j = 0; j < 8; ++j) kgr[j] = kg[128 + s8 * 8 + j];
  const float sgn = (s8 & 2) ? 1.f : -1.f;
  for (int r = blockIdx.x * 8 + wid; r < NR; r += gridDim.x * 8) {
    const bool lat = r < NLAT; const int t = r & 4095;
    bf16_t* kp = Kb + (size_t)r * LDK + hh * 192; const bf16_t* ur = U + (size_t)r * LDU;
    const int pos = (s8 < 4) ? (t >> 6) : (t & 63); const float* rp = rope + (pos * 16 + (s8 & 1) * 8) * 2;
    const u32x4 lk0 = *(const u32x4*)(kp + s8 * 16), lk1 = *(const u32x4*)(kp + s8 * 16 + 8), lkr = *(const u32x4*)(ur + C_CKR + s8 * 8);
    const bf16_t* hr = (const bf16_t*)(p.ws + WS_H) + (size_t)r * 1024;
    const u32x4 o00 = *(const u32x4*)(hr + c), o01 = *(const u32x4*)(hr + c + 8);
    const u32x4 o20 = *(const u32x4*)(ur + C_AC + c), o21 = *(const u32x4*)(ur + C_AC + c + 8), o30 = *(const u32x4*)(ur + C_BQ + c), o31 = *(const u32x4*)(ur + C_BQ + c + 8);
    const u32x4 lz0 = *(const u32x4*)(ur + C_BZ + c), lz1 = *(const u32x4*)(ur + C_BZ + c + 8);
    f32x4 rc0 = {1.f, 0.f, 1.f, 0.f}, rc1 = rc0, rc2 = rc0, rc3 = rc0;
    if (lat) { rc0 = *(const f32x4*)rp; rc1 = *(const f32x4*)(rp + 4); rc2 = *(const f32x4*)(rp + 8); rc3 = *(const f32x4*)(rp + 12); }
    const float cs[8] = {rc0[0], rc0[2], rc1[0], rc1[2], rc2[0], rc2[2], rc3[0], rc3[2]}, sn[8] = {rc0[1], rc0[3], rc1[1], rc1[3], rc2[1], rc2[3], rc3[1], rc3[3]};
    { float x[16], kr[8];
      unpack8(lk0, x); unpack8(lk1, x + 8); unpack8(lkr, kr);
      float ss = 0.f;
#pragma unroll
      for (int j = 0; j < 16; ++j) ss += x[j] * x[j];
#pragma unroll
      for (int j = 0; j < 8; ++j) ss += kr[j] * kr[j];
      ss += __shfl_xor(ss, 1, 64); ss += __shfl_xor(ss, 2, 64); ss += __shfl_xor(ss, 4, 64);
      const float rstd = rsqrtf(ss * (1.f / 192.f) + EPS);
#pragma unroll
      for (int j = 0; j < 16; ++j) x[j] *= rstd * kgn[j];
#pragma unroll
      for (int j = 0; j < 8; ++j) kr[j] *= rstd * kgr[j];
      if (!dry) { *(u32x4*)(kp + s8 * 16) = pack8(x); *(u32x4*)(kp + s8 * 16 + 8) = pack8(x + 8); }
#pragma unroll
      for (int j = 0; j < 8; ++j) { const float pr = __shfl_xor(kr[j], 2, 64); x[j] = kr[j] * cs[j] + sgn * pr * sn[j]; }
      if (!dry) *(u32x4*)(kp + 128 + s8 * 8) = pack8(x);
    }
    { float of[16], ob[16];
      unpack8(o00, of); unpack8(o01, of + 8);
      unpack8(o20, ob); unpack8(o21, ob + 8);
#pragma unroll
      for (int j = 0; j < 16; ++j) of[j] += ob[j];
      unpack8(o30, ob); unpack8(o31, ob + 8);
      float ss = 0.f;
#pragma unroll
      for (int j = 0; j < 16; ++j) { of[j] += ob[j]; ss += of[j] * of[j]; }
#pragma unroll
      for (int m = 8; m >= 1; m >>= 1) ss += __shfl_xor(ss, m, 64);
      const float rstd = rsqrtf(ss * (1.f / 256.f) + EPS);
      unpack8(lz0, ob); unpack8(lz1, ob + 8);
#pragma unroll
      for (int j = 0; j < 16; ++j) of[j] = of[j] * rstd * gg[j] * siluf(ob[j]);
      bf16_t* yb = YB + (size_t)r * 1024 + c;
      *(u32x4*)yb = pack8(of); *(u32x4*)(yb + 8) = pack8(of + 8); }
  }
}

namespace att {
constexpr int KVBLK = 64;
constexpr float SCALE = 0.07216878364870322f;
constexpr float THR = 8.f;
constexpr int SHM_V = 64 * 128 * 2, SHM_K = 64 * 192 * 2;
#define KSWZ(row, colB) ((row) * 384 + ((colB) ^ (((row) & 7) << 4)))
#define SBAR() __builtin_amdgcn_sched_barrier(0)
__device__ __forceinline__ int crow(int r, int hi) { return (r & 3) + 8 * (r >> 2) + 4 * hi; }
__device__ __forceinline__ void partialSM(f32x16& p0, f32x16& p1, float& m_reg, float& mn, float& alpha) {
  constexpr float C = SCALE * 1.4426950408889634f;
  float pmax = p0[0];
#pragma unroll
  for (int r = 1; r < 16; ++r) pmax = fmaxf(pmax, p0[r]);
#pragma unroll
  for (int r = 0; r < 16; ++r) pmax = fmaxf(pmax, p1[r]);
  { auto rr = __builtin_amdgcn_permlane32_swap(__float_as_uint(pmax), __float_as_uint(pmax), false, false);
    pmax = fmaxf(__uint_as_float(rr[0]), __uint_as_float(rr[1])); }
  if (__builtin_expect(__all(pmax - m_reg <= THR / SCALE), 1)) { mn = m_reg; alpha = 1.f; }
  else { mn = fmaxf(m_reg, pmax); alpha = __builtin_amdgcn_exp2f((m_reg - mn) * C); m_reg = mn; }
  const float mnC = -mn * C;
#pragma unroll
  for (int r = 0; r < 16; ++r) p0[r] = fmaf(p0[r], C, mnC);
#pragma unroll
  for (int r = 0; r < 16; ++r) p1[r] = fmaf(p1[r], C, mnC);
#pragma unroll
  for (int r = 0; r < 16; ++r) p0[r] = __builtin_amdgcn_exp2f(p0[r]);
}
__device__ __forceinline__ void finishSM(f32x16& p0, f32x16& p1, float alpha, float& l_reg, bf16x8& pa0, bf16x8& pa1, bf16x8& pa2, bf16x8& pa3) {
#pragma unroll
  for (int r = 0; r < 16; ++r) p1[r] = __builtin_amdgcn_exp2f(p1[r]);
  float ps = 0;
#pragma unroll
  for (int r = 0; r < 16; ++r) ps += p0[r];
#pragma unroll
  for (int r = 0; r < 16; ++r) ps += p1[r];
  { auto rr = __builtin_amdgcn_permlane32_swap(__float_as_uint(ps), __float_as_uint(ps), false, false);
    ps = __uint_as_float(rr[0]) + __uint_as_float(rr[1]); }
  l_reg = l_reg * alpha + ps;
#define PK4(P, BASE, OUT) do { unsigned a0 = cvt_pk_bf16(P[BASE + 0], P[BASE + 1]), a1 = cvt_pk_bf16(P[BASE + 2], P[BASE + 3]);   \
    unsigned b0 = cvt_pk_bf16(P[BASE + 4], P[BASE + 5]), b1 = cvt_pk_bf16(P[BASE + 6], P[BASE + 7]);                              \
    auto r0 = __builtin_amdgcn_permlane32_swap(a0, b0, false, false); auto r1 = __builtin_amdgcn_permlane32_swap(a1, b1, false, false); \
    u32x4 w = {r0[0], r1[0], r0[1], r1[1]}; OUT = *reinterpret_cast<bf16x8*>(&w); } while (0)
  PK4(p0, 0, pa0); PK4(p0, 8, pa1); PK4(p1, 0, pa2); PK4(p1, 8, pa3);
#undef PK4
}
__device__ __forceinline__ void qkt(f32x16& p0, f32x16& p1, const unsigned char* Ks, const bf16x8* qr, int r32, int hi) {
  p0 = f32x16{}; p1 = f32x16{};
#pragma unroll
  for (int d0 = 0; d0 < 12; ++d0) { const int cb = (d0 * 16 + hi * 8) * 2;
    const bf16x8 b0 = *reinterpret_cast<const bf16x8*>(Ks + KSWZ(r32, cb));
    const bf16x8 b1 = *reinterpret_cast<const bf16x8*>(Ks + KSWZ(32 + r32, cb));
    p0 = __builtin_amdgcn_mfma_f32_32x32x16_bf16(b0, qr[d0], p0, 0, 0, 0);
    p1 = __builtin_amdgcn_mfma_f32_32x32x16_bf16(b1, qr[d0], p1, 0, 0, 0); }
}
__device__ __forceinline__ int v_st(int k, int c) { const int kk = (k & ~0xC) | ((k & 4) << 1) | ((k & 8) >> 1); return ((kk >> 3) * 4 + (c >> 5)) * 512 + ((kk & 7) * 32 + (c & 31)) * 2; }
__device__ __forceinline__ int v_rd_base(int lane) { return ((lane & 3) << 3) | (((lane >> 2) & 3) << 6) | (((lane >> 4) & 1) << 5) | (((lane >> 5) & 1) << 8); }
constexpr int v_rd_off(int d0, int ks, int half) { return d0 * 512 + ks * 4096 + half * 2048; }
template <int OFF> __device__ __forceinline__ s16x4 tr_read(int vb) {
  s16x4 r; asm volatile("ds_read_b64_tr_b16 %0, %1 offset:%2" : "=&v"(r) : "v"(vb), "i"(OFF) : "memory"); return r;
}
template <int D0> __device__ __forceinline__ void pv_one(f32x16& od, int vb, bf16x8 pa0, bf16x8 pa1, bf16x8 pa2, bf16x8 pa3) {
  const s16x4 l0 = tr_read<v_rd_off(D0, 0, 0)>(vb), h0 = tr_read<v_rd_off(D0, 0, 1)>(vb), l1 = tr_read<v_rd_off(D0, 1, 0)>(vb), h1 = tr_read<v_rd_off(D0, 1, 1)>(vb);
  const s16x4 l2 = tr_read<v_rd_off(D0, 2, 0)>(vb), h2 = tr_read<v_rd_off(D0, 2, 1)>(vb), l3 = tr_read<v_rd_off(D0, 3, 0)>(vb), h3 = tr_read<v_rd_off(D0, 3, 1)>(vb);
  asm volatile("s_waitcnt lgkmcnt(0)" ::: "memory"); SBAR();
#define PK(L, H) (bf16x8){L[0], L[1], L[2], L[3], H[0], H[1], H[2], H[3]}
  od = __builtin_amdgcn_mfma_f32_32x32x16_bf16(pa0, PK(l0, h0), od, 0, 0, 0);
  od = __builtin_amdgcn_mfma_f32_32x32x16_bf16(pa1, PK(l1, h1), od, 0, 0, 0);
  od = __builtin_amdgcn_mfma_f32_32x32x16_bf16(pa2, PK(l2, h2), od, 0, 0, 0);
  od = __builtin_amdgcn_mfma_f32_32x32x16_bf16(pa3, PK(l3, h3), od, 0, 0, 0);
#undef PK
}
__device__ __forceinline__ void pv_d0(f32x16* o, int vb, bf16x8 pa0, bf16x8 pa1, bf16x8 pa2, bf16x8 pa3) {
  pv_one<0>(o[0], vb, pa0, pa1, pa2, pa3); pv_one<1>(o[1], vb, pa0, pa1, pa2, pa3); pv_one<2>(o[2], vb, pa0, pa1, pa2, pa3); pv_one<3>(o[3], vb, pa0, pa1, pa2, pa3);
}
__device__ __forceinline__ void attn_body(const bf16_t* __restrict__ Qg, const bf16_t* __restrict__ Kg, const bf16_t* __restrict__ Vg, const bf16_t* __restrict__ U, bf16_t* __restrict__ Yc,
                                          int qrow0, int h, int klat0, int nlt, int kctx0, int nct, unsigned char* lds, bool dry, const float* __restrict__ qg, const float* __restrict__ rope, bool qlat) {
  const int tid = otid(), wid = tid >> 6, lane = tid & 63, r32 = lane & 31, hi = lane >> 5;
  unsigned char* V_lds = lds; unsigned char* K_lds = lds + 2 * SHM_V;
  float* wsf = (float*)(lds + 2 * SHM_V + 2 * SHM_K) + wid * 64; float* li_l = wsf; float* al_l = wsf + 32;
  float m_reg = -1e30f, l_reg = 0; f32x16 o[4] = {}; bf16x8 qr[12];
  const bf16_t* Qw = Qg + (size_t)(qrow0 + wid * 32 + r32) * LDQ + h * 192 + hi * 8;
  {
    u32x4 raw[12]; float ss = 0.f;
#pragma unroll
    for (int d0 = 0; d0 < 12; ++d0) { raw[d0] = *reinterpret_cast<const u32x4*>(Qw + d0 * 16); float f[8]; unpack8(raw[d0], f);
#pragma unroll
      for (int j = 0; j < 8; ++j) ss += f[j] * f[j]; }
    ss += __shfl_xor(ss, 32, 64);
    const float rstd = rsqrtf(ss * (1.f / 192.f) + EPS);
    float xa[8];
#pragma unroll
    for (int d0 = 0; d0 < 12; ++d0) {
      float f[8]; unpack8(raw[d0], f);
      const f32x4 g0 = *(const f32x4*)(qg + d0 * 16 + hi * 8), g1 = *(const f32x4*)(qg + d0 * 16 + hi * 8 + 4);
#pragma unroll
      for (int j = 0; j < 4; ++j) { f[j] *= rstd * g0[j]; f[4 + j] *= rstd * g1[j]; }
      if (d0 == 8 || d0 == 10) {
#pragma unroll
        for (int j = 0; j < 8; ++j) xa[j] = f[j];
      } else if (d0 == 9 || d0 == 11) {
        const int t = (qrow0 + wid * 32 + r32) & 4095; const int pos = (d0 == 9) ? (t >> 6) : (t & 63);
        const float* rp = rope + (pos * 16 + hi * 8) * 2;
        float lo[8];
#pragma unroll
        for (int j = 0; j < 8; ++j) { float cs = 1.f, sn = 0.f; if (qlat) { cs = rp[2 * j]; sn = rp[2 * j + 1]; }
          lo[j] = xa[j] * cs - f[j] * sn; f[j] = f[j] * cs + xa[j] * sn; }
        u32x4 w = pack8(lo); qr[d0 - 1] = *reinterpret_cast<bf16x8*>(&w);
      }
      if (d0 != 8 && d0 != 10) { u32x4 w = pack8(f); qr[d0] = *reinterpret_cast<bf16x8*>(&w); }
    }
  }
  const int sr = tid >> 4, sc = (tid & 15) * 8, vst0 = v_st(sr, sc), vst1 = v_st(32 + sr, sc);
  const int kr0 = tid / 24, kc0 = (tid % 24), kr1 = (tid + 512) / 24, kc1 = (tid + 512) % 24, kr2 = (tid + 1024) / 24, kc2 = (tid + 1024) % 24;
  const int vb0 = (int)(uintptr_t)V_lds + v_rd_base(lane);
  const int NT = nlt + nct;
  bf16x8 vs0, vs1, ks0, ks1, ks2;
#define TROW(t) ((t) < nlt ? klat0 + (t) * 64 : kctx0 + ((t) - nlt) * 64)
#define SLOAD(t) do { const int k0_ = TROW(t); vs0 = *reinterpret_cast<const bf16x8*>(Vg + (size_t)(k0_ + sr) * LDV + h * 128 + sc); vs1 = *reinterpret_cast<const bf16x8*>(Vg + (size_t)(k0_ + 32 + sr) * LDV + h * 128 + sc); \
    ks0 = *reinterpret_cast<const bf16x8*>(Kg + (size_t)(k0_ + kr0) * LDK + h * 192 + kc0 * 8); ks1 = *reinterpret_cast<const bf16x8*>(Kg + (size_t)(k0_ + kr1) * LDK + h * 192 + kc1 * 8); \
    ks2 = *reinterpret_cast<const bf16x8*>(Kg + (size_t)(k0_ + kr2) * LDK + h * 192 + kc2 * 8); } while (0)
#define SWRITE(b) do { *(bf16x8*)(V_lds + (b) * SHM_V + vst0) = vs0; *(bf16x8*)(V_lds + (b) * SHM_V + vst1) = vs1; \
    *(bf16x8*)(K_lds + (b) * SHM_K + KSWZ(kr0, kc0 * 16)) = ks0; *(bf16x8*)(K_lds + (b) * SHM_K + KSWZ(kr1, kc1 * 16)) = ks1; *(bf16x8*)(K_lds + (b) * SHM_K + KSWZ(kr2, kc2 * 16)) = ks2; } while (0)
#define SWAIT() asm volatile("s_waitcnt vmcnt(0)" ::: "memory")
#define RESC(a) do { if (__any((a) < 1.f)) { if (hi == 0) al_l[r32] = (a); asm volatile("s_waitcnt lgkmcnt(0)" ::: "memory"); \
    _Pragma("unroll") for (int d = 0; d < 4; ++d) _Pragma("unroll") for (int r = 0; r < 16; ++r) o[d][r] *= al_l[crow(r, hi)]; } } while (0)
  f32x16 p0, p1; float mn, al; bf16x8 pa0, pa1, pa2, pa3;
  SLOAD(0); SWAIT(); SWRITE(0); if (NT > 1) SLOAD(1);
  for (int j = 0; j < NT; ++j) {
    __syncthreads();
    if (j + 1 < NT) { SWAIT(); SWRITE((j + 1) & 1); }
    if (j + 2 < NT) SLOAD(j + 2);
    SBAR(); qkt(p0, p1, K_lds + (j & 1) * SHM_K, qr, r32, hi);
    partialSM(p0, p1, m_reg, mn, al);
    RESC(al);
    finishSM(p0, p1, al, l_reg, pa0, pa1, pa2, pa3); SBAR();
    pv_d0(o, vb0 + (j & 1) * SHM_V, pa0, pa1, pa2, pa3);
  }
  if (hi == 0) li_l[r32] = l_reg; asm volatile("s_waitcnt lgkmcnt(0)" ::: "memory");
  float rli[16];
#pragma unroll
  for (int r = 0; r < 16; ++r) rli[r] = __builtin_amdgcn_rcpf(li_l[crow(r, hi)]);
  __syncthreads();
  if (dry) return;
  unsigned char* ot = lds + wid * 8704;
#pragma unroll
  for (int r = 0; r < 16; ++r) { const int orow = crow(r, hi);
#pragma unroll
    for (int d0 = 0; d0 < 4; ++d0) *(bf16_t*)(ot + orow * 272 + (d0 * 32 + r32) * 2) = f2bf(o[d0][r] * rli[r]); }
  asm volatile("s_waitcnt lgkmcnt(0)" ::: "memory");
  const bf16_t* Ow = U + (size_t)(qrow0 + wid * 32) * LDU + C_CZ + h * 128;
  bf16_t* Yw = Yc + (size_t)(qrow0 + wid * 32) * 1024 + h * 128;
#pragma unroll
  for (int i = 0; i < 8; ++i) { const int ci = i * 64 + lane, orow = ci >> 4, c8 = (ci & 15) * 8;
    float ov[8], zv[8];
    unpack8(*(const u32x4*)(ot + orow * 272 + c8 * 2), ov); unpack8(*(const u32x4*)(Ow + (size_t)orow * LDU + c8), zv);
#pragma unroll
    for (int j = 0; j < 8; ++j) ov[j] *= siluf(zv[j]);
    *(u32x4*)(Yw + (size_t)orow * 1024 + c8) = pack8(ov); }
#undef TROW
#undef SLOAD
#undef SWRITE
#undef SWAIT
#undef RESC
}
}

__device__ __forceinline__ void phase_attention(const Params& p, int l, unsigned char* lds, bool dry = false) {
  const bf16_t* Qb = (const bf16_t*)(p.ws + WS_Q); const bf16_t* Kb = (const bf16_t*)(p.ws + WS_K); const bf16_t* Vb = (const bf16_t*)(p.ws + WS_V);
  bf16_t* U = (bf16_t*)(p.ws + WS_U);
  const int nitems = 512 + (l < DEPTH - 1 ? 32 : 0);
  for (int it = blockIdx.x; it < nitems; it += gridDim.x) {
    __syncthreads();
    int qrow0, h, b, nlt;
    if (it < 512) { const int cc_ = it & 255, rd_ = it >> 8, slot_ = cc_ >> 3, pair_ = (cc_ & 7) * 4 + rd_ * 2 + (slot_ >> 4);
      const int qb = slot_ & 15; h = pair_ & 7; b = pair_ >> 3; qrow0 = b * 4096 + qb * 256; nlt = 64; }
    else { const int j = it - 512; h = j & 7; b = j >> 3; qrow0 = NLAT + b * 256; nlt = 0; }
    att::attn_body(Qb, Kb, Vb, U, (bf16_t*)(p.ws + WS_YC), qrow0, h, b * 4096, nlt, NLAT + b * 256, 4, lds, dry, p.in[18] + l * 192, (const float*)(p.ws + WS_ROPE), it < 512);
  }
}

#define XB_TMO      128
#define XB_XCNT(j)  (256  + 64 * (j))
#define XB_XSUB(j)  (1280 + 64 * (j))
#define XB_XGEN(j)  (2304 + 64 * (j))
#define XB_TOP      3328
#define XB_TOPGEN   3392
constexpr int XCD_BAR_WORDS = 3456;
#define XB_SPIN_CAP (1u << 18)

__device__ __forceinline__ unsigned xb_ld(unsigned* p)              { return __hip_atomic_load(p, __ATOMIC_RELAXED, __HIP_MEMORY_SCOPE_AGENT); }
__device__ __forceinline__ unsigned xb_add(unsigned* p, unsigned v) { return __hip_atomic_fetch_add(p, v, __ATOMIC_RELAXED, __HIP_MEMORY_SCOPE_AGENT); }
__device__ __forceinline__ unsigned xb_xcc_id() { return (unsigned)__builtin_amdgcn_s_getreg((3 << 11) | 20) & 0xFu; }
#define XB_SPIN(cond, bar) do { unsigned _sp = 0; while (cond) { __builtin_amdgcn_s_sleep(1); \
    if ((++_sp & 255u) == 0u) { if (xb_ld(&(bar)[XB_TMO])) break; if (_sp > XB_SPIN_CAP) { atomicAdd(&(bar)[XB_TMO], 1u); break; } } } } while (0)

struct XcdBarrier {
    unsigned* bar; unsigned x;
    volatile LAS unsigned* st;
};

__device__ __forceinline__ XcdBarrier xcd_barrier_post(unsigned* bar, volatile LAS unsigned* st) {
    XcdBarrier b; b.bar = bar; b.x = xb_xcc_id(); b.st = st;
    if (threadIdx.x == 0) (void)xb_add(&bar[XB_XCNT(b.x)], 1u);
    return b;
}
__device__ __forceinline__ void xcd_barrier_complete(unsigned* bar, unsigned x, unsigned& nloc, unsigned& nx) {
    const unsigned G = gridDim.x * gridDim.y * gridDim.z;
    unsigned sum, cnt, mine, sp = 0u;
    for (;;) {
        sum = 0u; cnt = 0u; mine = 0u;
#pragma unroll
        for (unsigned j = 0; j < 16; ++j) { const unsigned c = xb_ld(&bar[XB_XCNT(j)]); sum += c; cnt += (c > 0u) ? 1u : 0u; mine = (j == x) ? c : mine; }
        if (sum == G) break;
        __builtin_amdgcn_s_sleep(1);
        if ((++sp & 255u) == 0u) { if (xb_ld(&bar[XB_TMO])) break; if (sp > XB_SPIN_CAP) { atomicAdd(&bar[XB_TMO], 1u); break; } }
    }
    nloc = mine > 0u ? mine : 1u; nx = cnt > 0u ? cnt : 1u;
}

__device__ __forceinline__ void xcd_barrier(const XcdBarrier& b) {
    asm volatile("s_waitcnt vmcnt(0)" ::: "memory");
    __syncthreads();
    if (threadIdx.x == 0) {
        unsigned* bar = b.bar;
        __builtin_amdgcn_s_waitcnt(0);
        unsigned nloc = b.st[0], nx = b.st[1];
        if (nloc == 0u) { xcd_barrier_complete(bar, b.x, nloc, nx); b.st[0] = nloc; b.st[1] = nx; }
        const unsigned old = xb_add(&bar[XB_XSUB(b.x)], 1u);
        const unsigned gen = old / nloc;
        if (old + 1u == (gen + 1u) * nloc) {
            __builtin_amdgcn_fence(__ATOMIC_RELEASE, "agent");
            asm volatile("s_waitcnt vmcnt(0)" ::: "memory");
            const unsigned og = xb_add(&bar[XB_TOP], 1u);
            const unsigned tg = og / nx;
            if (og + 1u == (tg + 1u) * nx) xb_add(&bar[XB_TOPGEN], 1u);
            else XB_SPIN(xb_ld(&bar[XB_TOPGEN]) == tg, bar);
            __builtin_amdgcn_fence(__ATOMIC_ACQUIRE, "agent");
            xb_add(&bar[XB_XGEN(b.x)], 1u);
            asm volatile("s_waitcnt vmcnt(0)" ::: "memory");
        } else {
            XB_SPIN(xb_ld(&bar[XB_XGEN(b.x)]) == gen, bar);
            __builtin_amdgcn_fence(__ATOMIC_ACQUIRE, "agent");
            asm volatile("s_waitcnt vmcnt(0)" ::: "memory");
        }
    }
    __syncthreads();
}

#ifndef PH_MASK
#define PH_MASK 0xFFFF
#endif
#ifndef REP_MASK
#define REP_MASK 0
#endif
#define PH(i) for (int rep_ = 0; rep_ < 1 + ((REP_MASK >> (i)) & 1); ++rep_) if constexpr ((PH_MASK >> (i)) & 1)
#define GSYNC() xcd_barrier(xb)
__global__ void __launch_bounds__(512, 2) fwd_megakernel(Params p) {
  extern __shared__ __attribute__((aligned(16))) unsigned char lds[];
  cg::grid_group grid = cg::this_grid();
  LAS unsigned char* ldsl = (LAS unsigned char*)lds;
  const int G = gridDim.x, c = blockIdx.x;
  bf16_t* U = (bf16_t*)(p.ws + WS_U);
  volatile LAS unsigned* bst = (volatile LAS unsigned*)(ldsl + LDS_BYTES - 16);
  if (threadIdx.x < 4) bst[threadIdx.x] = 0u;
  __syncthreads();
  const XcdBarrier xb = xcd_barrier_post((unsigned*)(p.ws + WS_BAR), bst);
  PH(0) phase_mod(p, lds);
  GSYNC();
  { const int i_ = blockIdx.x * 512 + threadIdx.x;
    if (i_ < DEPTH * 5 * 3072) { const float* pp = (const float*)(p.ws + WS_K) + i_; float sacc = 0.f;
      for (int j_ = 0; j_ < 32; ++j_) sacc += pp[(size_t)j_ * (DEPTH * 5 * 3072)];
      ((float*)(p.ws + WS_MOD))[i_] = sacc; } }
  asm volatile("s_waitcnt vmcnt(0)" ::: "memory"); grid.sync();
  for (int l = 0; l < DEPTH; ++l) {
    const float* mod = (const float*)(p.ws + WS_MOD) + (size_t)l * 5 * 3072;
    PH(1) phase_norm_convert(p, l, lds);
    GSYNC();
    PH(2) {
      SchedSimple S{(const char*)(p.ws + WS_H), (const char*)(p.ws + WS_WIN), NR / 256, LDU / 256, G, c, (size_t)256 * 1024 * 2, (size_t)256 * 1024 * 2};
      pg8::EpiRow<FStoreBf16> E{{U, LDU}};
      pg8::gemm_phase(ldsl, 1024, 1024, 1024, S, E);
    }
    GSYNC();
    PH(3) phase_prep(p, l, rep_ < ((REP_MASK >> 3) & 1));
    PH(4) phase_gla_intra(p, l, lds, c, G);
    GSYNC();
    PH(9) {
      { SchedSimple S{(const char*)(p.ws + WS_CN), (const char*)(p.ws + WS_WQ), NR / 256, 1536 / 256, G, c, (size_t)256 * 512 * 2, (size_t)256 * 384 * 2};
        pg8::EpiRow<FStoreBf16> E{{(bf16_t*)(p.ws + WS_Q), LDQ}};
        pg8::gemm_phase(ldsl, 384, 512, 384, S, E); }
      { SchedSimple S{(const char*)(p.ws + WS_CN) + 384 * 2, (const char*)(p.ws + WS_WKV), NR / 256, 2048 / 256, G, c, (size_t)256 * 512 * 2, (size_t)256 * 256 * 2};
        pg8::EpiRow<FStoreKV> E{{(bf16_t*)(p.ws + WS_K), (bf16_t*)(p.ws + WS_V)}};
        pg8::gemm_phase(ldsl, 256, 512, 256, S, E); }
      __syncthreads();
      for (int it = c; it < 256; it += G) phase_gla_inter(p, l, lds, it);
    }
    GSYNC();
    PH(5) phase_qknorm_yb(p, l, rep_ < ((REP_MASK >> 5) & 1));
    GSYNC();
    PH(6) phase_attention(p, l, lds, rep_ < ((REP_MASK >> 6) & 1));
    GSYNC();
    PH(7) {
      SchedMerge S{(const char*)(p.ws + WS_YA), (const char*)(p.ws + WS_YB), (const char*)(p.ws + WS_YC), (const char*)(p.ws + WS_WBR), G, c, (l == DEPTH - 1) ? 0 : 48, (size_t)256 * 1024 * 2, (size_t)256 * 1024 * 2};
      pg8::EpiRow<FMerge> E{{U, (bf16_t*)(p.ws + WS_H), (bf16_t*)(p.ws + WS_MC)}};
      pg8::gemm_phase(ldsl, 1024, 1024, 1024, S, E);
      if (l + 1 < DEPTH && G > 48 && c >= 48) convert_range(p, l + 1, lds, 0, 2080, c - 48, G - 48);
    }
    GSYNC();
    PH(8) {
      SchedOut S{(const char*)(p.ws + WS_H), (const char*)(p.ws + WS_MC), (const char*)(p.ws + WS_WOUT), G, c, (l == DEPTH - 1) ? 0 : 48, (size_t)256 * 1024 * 2};
      pg8::EpiRow<FOut> E{{l == 0 ? p.in[0] : p.out, p.out, (float*)(p.ws + WS_Q), mod, l, rep_ < ((REP_MASK >> 8) & 1)}};
      pg8::gemm_phase(ldsl, 1024, 1024, 1024, S, E);
      if (l + 1 < DEPTH && G > 48 && c >= 48) convert_range(p, l + 1, lds, 2080, 4048, c - 48, G - 48);
    }
    GSYNC();
  }
}

extern "C" void kernel_launch(void* const* d_in, const int* in_sizes, int n_in, void* d_out, int out_size, void* d_ws, size_t ws_size, hipStream_t stream) {
  static int grid = 0;
  if (grid == 0) {
    if (n_in != 24 || out_size != NLAT * DM || ws_size < WS_END) { fprintf(stderr, "kernel_launch: unexpected shapes (n_in %d out %d ws %zu, need ws >= %zu)\n", n_in, out_size, ws_size, (size_t)WS_END); grid = -1; return; }
    int dev = 0, cus = 0, per_cu = 0;
    hipGetDevice(&dev); hipDeviceGetAttribute(&cus, hipDeviceAttributeMultiprocessorCount, dev);
    if (hipFuncSetAttribute((const void*)fwd_megakernel, hipFuncAttributeMaxDynamicSharedMemorySize, LDS_BYTES) != hipSuccess) { fprintf(stderr, "kernel_launch: hipFuncSetAttribute failed\n"); grid = -1; return; }
    if (hipOccupancyMaxActiveBlocksPerMultiprocessor(&per_cu, (const void*)fwd_megakernel, 512, LDS_BYTES) != hipSuccess || per_cu < 1) { fprintf(stderr, "kernel_launch: occupancy query says %d\n", per_cu); per_cu = 1; }
    (void)hipGetLastError();
    grid = cus;
  }
  if (grid < 0) return;
  hipMemsetAsync((char*)d_ws + WS_BAR, 0, (size_t)3456 * 4, stream);
#ifdef LDS_PROBE
  hipMemsetAsync((char*)d_ws + WS_ROPE + 8192, 0, 256, stream);
#endif
  Params p{};
  for (int i = 0; i < 24; ++i) p.in[i] = (const float*)d_in[i];
  p.out = (float*)d_out; p.ws = (unsigned char*)d_ws;
  void* args[] = {&p};
  hipError_t e = hipLaunchCooperativeKernel((const void*)fwd_megakernel, dim3(grid), dim3(512), args, LDS_BYTES, stream);
  if (e != hipSuccess) fprintf(stderr, "cooperative launch failed: %s (grid %d)\n", hipGetErrorString(e), grid);
}
```

```cpp
#include <hip/hip_runtime.h>
#include <hip/hip_cooperative_groups.h>
#include <cstdio>
#include <cstdint>
namespace cg = cooperative_groups;
#ifndef GLA_DBG
#define GLA_DBG 0
#endif

#define LAS __attribute__((address_space(3)))
typedef unsigned short bf16_t;
typedef short bf16x8 __attribute__((ext_vector_type(8)));
typedef short s16x4 __attribute__((ext_vector_type(4)));
typedef float f32x4 __attribute__((ext_vector_type(4)));
typedef float f32x16 __attribute__((ext_vector_type(16)));
typedef unsigned u32x4 __attribute__((ext_vector_type(4)));
typedef unsigned u32x2 __attribute__((ext_vector_type(2)));

constexpr int DM = 1024, NB = 4, SEQ = 4096, DEPTH = 4, CTXL = 256;
constexpr int NLAT = NB * SEQ, NCTX = NB * CTXL, NR = NLAT + NCTX;
constexpr int IN_DIM = 11872, LDU = 12032;
constexpr int C_AV = 0, C_AB = 1024, C_AC = 2048, C_AZ = 3072, C_BQ = 4096, C_BK = 4608, C_BV = 5120, C_BZ = 6144, C_BAF = 7168, C_BAB = 7184,
              C_CQ = 7200, C_CKV = 7584, C_CKR = 7712, C_CZ = 7776, C_GA = 8800;
constexpr int LDQ = 1536, LDK = 1536, LDV = 1024;
constexpr float EPS = 1e-6f;
constexpr size_t al256(size_t x) { return (x + 255) / 256 * 256; }
constexpr size_t WS_U = 0;
constexpr size_t WS_WIN = al256(WS_U + (size_t)NR * LDU * 2);
constexpr size_t WS_WQ = al256(WS_WIN + (size_t)LDU * 1024 * 2);
constexpr size_t WS_WKV = al256(WS_WQ + (size_t)1536 * 384 * 2);
constexpr size_t WS_WBR = al256(WS_WKV + (size_t)2048 * 256 * 2);
constexpr size_t WS_WOUT = al256(WS_WBR + (size_t)3 * 1024 * 1024 * 2);
constexpr size_t WS_H = al256(WS_WOUT + (size_t)1024 * 1024 * 2);
constexpr size_t WS_Q = al256(WS_H + (size_t)NR * 1024 * 2);
constexpr size_t WS_K = al256(WS_Q + (size_t)NR * LDQ * 2);
constexpr size_t WS_V = al256(WS_K + (size_t)NR * LDK * 2);
constexpr size_t WS_CTX = al256(WS_V + (size_t)NR * LDV * 2);
constexpr size_t WS_MOD = al256(WS_CTX + (size_t)NCTX * 1024 * 4);
constexpr size_t WS_ROPE = al256(WS_MOD + (size_t)DEPTH * 5 * 3072 * 4);
constexpr size_t WS_QD = al256(WS_ROPE + 64 * 16 * 2 * 4 + 256);
constexpr size_t WS_KET = al256(WS_QD + (size_t)2 * NR * 512 * 2);
constexpr size_t WS_GD = al256(WS_KET + (size_t)2 * NR * 512 * 2);
constexpr size_t WS_BAR = al256(WS_GD + (size_t)2 * 16 * 68 * 128 * 4);
constexpr size_t WS_YA = al256(WS_BAR + 3456 * 4);
constexpr size_t WS_MC = al256(WS_YA + (size_t)NR * 1024 * 2);
constexpr size_t WS_CN = al256(WS_MC + (size_t)3 * 1024 * 1024 * 2);
constexpr size_t WS_END = al256(WS_CN + (size_t)NR * 512 * 2 + 1024);
constexpr size_t WS_YB = WS_QD, WS_YC = WS_KET;
static_assert(WS_END <= 778043392ull, "workspace budget");
constexpr int LDS_BYTES = 147456;

struct Params { const float* in[24]; float* out; unsigned char* ws; };

__device__ __forceinline__ float bf2f(unsigned b) { return __uint_as_float(b << 16); }
__device__ __forceinline__ float bflo(unsigned w) { return __uint_as_float(w << 16); }
__device__ __forceinline__ float bfhi(unsigned w) { return __uint_as_float(w & 0xffff0000u); }
typedef __bf16 bf16x2_t __attribute__((ext_vector_type(2)));
typedef float f32x2_t __attribute__((ext_vector_type(2)));
__device__ __forceinline__ unsigned cvt_pk_bf16(float lo, float hi) { f32x2_t v = {lo, hi}; bf16x2_t b = __builtin_convertvector(v, bf16x2_t); return __builtin_bit_cast(unsigned, b); }
__device__ __forceinline__ bf16_t f2bf(float x) { return (bf16_t)(cvt_pk_bf16(x, 0.f) & 0xffffu); }
__device__ __forceinline__ int otid() { int t = threadIdx.x; asm volatile("" : "+v"(t)); return t; }
__device__ __forceinline__ int obid() { int t = blockIdx.x; asm volatile("" : "+s"(t)); return t; }
__device__ __forceinline__ float sigmf(float x) { return __builtin_amdgcn_rcpf(1.f + __builtin_amdgcn_exp2f(x * -1.4426950408889634f)); }
__device__ __forceinline__ float siluf(float x) { return x * sigmf(x); }
__device__ __forceinline__ float wave_sum(float v) {
#pragma unroll
  for (int m = 32; m >= 1; m >>= 1) v += __shfl_xor(v, m, 64);
  return v;
}
__device__ __forceinline__ void unpack8(u32x4 w, float* f) {
  f[0] = bflo(w[0]); f[1] = bfhi(w[0]); f[2] = bflo(w[1]); f[3] = bfhi(w[1]); f[4] = bflo(w[2]); f[5] = bfhi(w[2]); f[6] = bflo(w[3]); f[7] = bfhi(w[3]);
}
__device__ __forceinline__ u32x4 pack8(const float* f) {
  u32x4 w; w[0] = cvt_pk_bf16(f[0], f[1]); w[1] = cvt_pk_bf16(f[2], f[3]); w[2] = cvt_pk_bf16(f[4], f[5]); w[3] = cvt_pk_bf16(f[6], f[7]); return w;
}

namespace pg8 {
constexpr int BM = 256, BK = 64, HALF = 128, HTB = HALF * BK * 2, STAGE_BYTES = 8 * HTB, NXCD = 8, WGM = 8;
__device__ __forceinline__ int lds_byte(int r, int c) { const int st = (r >> 4) * 2 + (c >> 5), rr = r & 15, cc = c & 31, ob = rr * 64 + cc * 2; return st * 1024 + (ob ^ (((ob >> 9) & 1) << 5)); }
__device__ __forceinline__ void stage_rc(int b, int& R, int& C) { const int st = b / 1024, sb = b % 1024, swz = sb ^ (((sb >> 9) & 1) << 5); R = (st >> 1) * 16 + swz / 64; C = (st & 1) * 32 + (swz % 64) / 2; }
__device__ __forceinline__ int perm32(int rho) { const int n = rho >> 4, i = rho & 15; return 8 * (i >> 2) + 4 * n + (i & 3); }
struct Unit { int pm, pn, z; };

__device__ __forceinline__ bool static_next(int nM, int nN, int G, int c, int i, Unit& u) {
  const int nwg = nM * nN; const long L = (long)i * G + c; if (L >= nwg) return false;
  int wgid = (int)L; { const int q = nwg / NXCD, r = nwg % NXCD, xcd = wgid % NXCD, off = wgid / NXCD; wgid = (xcd < r ? xcd * (q + 1) : r * (q + 1) + (xcd - r) * q) + off; }
  const int nig = WGM * nN, gid = wgid / nig, fm = gid * WGM, gsz = (nM - fm) < WGM ? (nM - fm) : WGM;
  u.pm = fm + ((wgid % nig) % gsz); u.pn = (wgid % nig) / gsz; u.z = 0; return true;
}

template <class Epi, class Sched>
__device__ __forceinline__ void gemm_phase(LAS unsigned char* lds, const int K, const int lda, const int ldb, const Sched& S, const Epi& E) {
  const int tid = otid(), wid = __builtin_amdgcn_readfirstlane(tid >> 6), lane = tid & 63, wr = wid >> 2, wc = wid & 3, fr = lane & 15, fq = lane >> 4;
  const int nt = K / BK;
  unsigned voffA[2], voffB[2];
#pragma unroll
  for (int i = 0; i < 2; ++i) { int R, C; stage_rc(tid * 16 + i * 8192, R, C); const int Rb = (R & ~31) + perm32(R & 31);
    voffA[i] = (unsigned)(R * lda + C) * 2u; voffB[i] = (unsigned)(Rb * ldb + C) * 2u; }
  const size_t kstep = (size_t)(BK * 2);
  const size_t hstepA = (size_t)HALF * lda * 2, hstepB = (size_t)HALF * ldb * 2;
  const unsigned ldsw = (unsigned)wid * 1024u;
  const int aoff = lds_byte(wr * 64 + fr, fq * 8), boff = lds_byte(wc * 32 + fr, fq * 8);
#define PG8_SA(b, h) (((b) * 2 + (h)) * HTB)
#define PG8_SB(b, h) ((4 + (b) * 2 + (h)) * HTB)
#define PG8_STAGE(bufoff, gbase, voff) do { _Pragma("unroll") for (int _i = 0; _i < 2; ++_i) \
    __builtin_amdgcn_global_load_lds((const unsigned*)((const char*)(gbase) + (voff)[_i]), (LAS unsigned*)(lds + (bufoff) + ldsw + _i * 8192), 16, 0, 0); } while (0)
#define PG8_LDA(dst, b, h) do { _Pragma("unroll") for (int m = 0; m < 4; ++m) _Pragma("unroll") for (int k = 0; k < 2; ++k) dst[m][k] = *(const LAS bf16x8*)(lds + PG8_SA(b, h) + aoff + m * 2048 + k * 1024); } while (0)
#define PG8_LDB(dst, b, h) do { _Pragma("unroll") for (int n = 0; n < 2; ++n) _Pragma("unroll") for (int k = 0; k < 2; ++k) dst[n][k] = *(const LAS bf16x8*)(lds + PG8_SB(b, h) + boff + n * 2048 + k * 1024); } while (0)
#define PG8_MMA(ai, bj, At, Bt) do { __builtin_amdgcn_s_setprio(1); _Pragma("unroll") for (int m = 0; m < 4; ++m) _Pragma("unroll") for (int n = 0; n < 2; ++n) _Pragma("unroll") for (int k = 0; k < 2; ++k) \
    acc[ai][bj][m][n] = __builtin_amdgcn_mfma_f32_16x16x32_bf16(Bt[n][k], At[m][k], acc[ai][bj][m][n], 0, 0, 0); __builtin_amdgcn_s_setprio(0); } while (0)
#define PG8_WAIT_V(n) asm volatile("s_waitcnt vmcnt(" #n ")" ::: "memory")
#define PG8_WAIT_L(n) asm volatile("s_waitcnt lgkmcnt(" #n ")" ::: "memory")
#define PG8_BAR __builtin_amdgcn_s_barrier()
#define PG8_SCHED __builtin_amdgcn_sched_barrier(0)
  Unit cur, nxt; int ui = 0;
  if (!S.next(0, cur)) return;
  f32x4 acc[2][2][4][2];
#pragma unroll
  for (int a = 0; a < 2; ++a)
#pragma unroll
    for (int b = 0; b < 2; ++b)
#pragma unroll
      for (int m = 0; m < 4; ++m)
#pragma unroll
        for (int n = 0; n < 2; ++n) acc[a][b][m][n] = (f32x4){0.f, 0.f, 0.f, 0.f};
  bf16x8 At[4][2], B0[2][2], B1[2][2];
  const char* cA = S.aptr(cur); const char* cB = S.bptr(cur);
  PG8_STAGE(PG8_SB(0, 0), cB, voffB); PG8_STAGE(PG8_SA(0, 0), cA, voffA); PG8_STAGE(PG8_SB(0, 1), cB + hstepB, voffB); PG8_STAGE(PG8_SA(0, 1), cA + hstepA, voffA);
  if (wr == 1) PG8_BAR;
  PG8_WAIT_V(4); PG8_BAR;
  PG8_STAGE(PG8_SB(1, 0), cB + kstep, voffB); PG8_STAGE(PG8_SA(1, 0), cA + kstep, voffA); PG8_STAGE(PG8_SB(1, 1), cB + hstepB + kstep, voffB);
  PG8_WAIT_V(6); PG8_BAR;
  for (;;) {
    const bool has_next = S.next(ui + 1, nxt);
    const char* nA = has_next ? S.aptr(nxt) : cA; const char* nB = has_next ? S.bptr(nxt) : cB;
    for (int t = 0; t < nt; t += 2) {
      const bool last = (t == nt - 2);
      const char* a1 = cA + (size_t)(t + 1) * kstep;
      const char* a2 = last ? nA : cA + (size_t)(t + 2) * kstep; const char* b2 = last ? nB : cB + (size_t)(t + 2) * kstep;
      const char* a3 = a2 + kstep; const char* b3 = b2 + kstep;
      PG8_LDB(B0, 0, 0); PG8_SCHED; PG8_LDA(At, 0, 0); PG8_STAGE(PG8_SA(1, 1), a1 + hstepA, voffA);
      PG8_WAIT_L(8); PG8_BAR; PG8_WAIT_L(0); PG8_MMA(0, 0, At, B0); PG8_BAR; PG8_SCHED;
      PG8_LDB(B1, 0, 1); PG8_STAGE(PG8_SB(0, 0), b2, voffB);
      PG8_BAR; PG8_WAIT_L(0); PG8_MMA(0, 1, At, B1); PG8_BAR;
      PG8_LDA(At, 0, 1); PG8_STAGE(PG8_SA(0, 0), a2, voffA);
      PG8_BAR; PG8_WAIT_L(0); PG8_MMA(1, 0, At, B0); PG8_BAR; PG8_SCHED;
      PG8_STAGE(PG8_SB(0, 1), b2 + hstepB, voffB);
      PG8_WAIT_V(6); PG8_BAR; PG8_MMA(1, 1, At, B1); PG8_BAR;
      PG8_LDB(B0, 1, 0); PG8_SCHED; PG8_LDA(At, 1, 0); PG8_STAGE(PG8_SA(0, 1), a2 + hstepA, voffA);
      PG8_WAIT_L(8); PG8_BAR; PG8_WAIT_L(0); PG8_MMA(0, 0, At, B0); PG8_BAR; PG8_SCHED;
      PG8_LDB(B1, 1, 1); PG8_STAGE(PG8_SB(1, 0), b3, voffB);
      PG8_BAR; PG8_WAIT_L(0); PG8_MMA(0, 1, At, B1); PG8_BAR;
      PG8_LDA(At, 1, 1); PG8_STAGE(PG8_SA(1, 0), a3, voffA);
      PG8_BAR; PG8_WAIT_L(0); PG8_MMA(1, 0, At, B0); PG8_BAR; PG8_SCHED;
      PG8_STAGE(PG8_SB(1, 1), b3 + hstepB, voffB);
      PG8_WAIT_V(6); PG8_BAR; PG8_MMA(1, 1, At, B1); PG8_BAR;
    }
    E(acc, cur, wr, wc, fr, fq);
    if (!has_next) break;
#pragma unroll
    for (int a = 0; a < 2; ++a)
#pragma unroll
      for (int b = 0; b < 2; ++b)
#pragma unroll
        for (int m = 0; m < 4; ++m)
#pragma unroll
          for (int n = 0; n < 2; ++n) acc[a][b][m][n] = (f32x4){0.f, 0.f, 0.f, 0.f};
    cur = nxt; cA = nA; cB = nB; ++ui;
  }
  PG8_WAIT_V(0);
  if (wr == 0) PG8_BAR;
  PG8_BAR;
#undef PG8_SA
#undef PG8_SB
#undef PG8_STAGE
#undef PG8_LDA
#undef PG8_LDB
#undef PG8_MMA
#undef PG8_WAIT_V
#undef PG8_WAIT_L
#undef PG8_BAR
#undef PG8_SCHED
}

template <class F> struct EpiRow {
  F f;
  __device__ __forceinline__ void operator()(const f32x4 (&acc)[2][2][4][2], const Unit& u, int wr, int wc, int fr, int fq) const {
    const int row0 = u.pm * BM + wr * 64 + fr, col0 = u.pn * BM + wc * 32 + 8 * fq;
#pragma unroll
    for (int ai = 0; ai < 2; ++ai)
#pragma unroll
      for (int m = 0; m < 4; ++m)
#pragma unroll
        for (int bj = 0; bj < 2; ++bj) f(u, row0 + ai * HALF + m * 16, col0 + bj * HALF, acc[ai][bj][m][0], acc[ai][bj][m][1]);
  }
};
}
using pg8::Unit;

struct SchedSimple {
  const char* A; const char* Bt; int nM, nN, G, c; size_t tstepA, tstepB;
  __device__ __forceinline__ bool next(int i, Unit& u) const { return pg8::static_next(nM, nN, G, c, i, u); }
  __device__ __forceinline__ const char* aptr(const Unit& u) const { return A + (size_t)u.pm * tstepA; }
  __device__ __forceinline__ const char* bptr(const Unit& u) const { return Bt + (size_t)u.pn * tstepB; }
};
struct SchedMerge {
  const char* A0; const char* A1; const char* A2; const char* Bt; int G, c, nctx; size_t tstepA, tstepB;
  __device__ __forceinline__ bool next(int i, Unit& u) const {
    const int nl = c < 256 ? (256 - c + G - 1) / G : 0;
    if (i < 3 * nl) { const int ti = i / 3, z = i - ti * 3, t0 = ti * G + c, tile = (G == 256) ? ((t0 & 7) * 32 + (t0 >> 3)) : t0; u.pm = tile >> 2; u.pn = tile & 3; u.z = z; return true; }
    const int j = (i - 3 * nl) * G + c; if (j >= nctx) return false;
    const int tile = j / 3; u.pm = 64 + (tile >> 2); u.pn = tile & 3; u.z = 4 + (j - tile * 3); return true; }
  __device__ __forceinline__ const char* aptr(const Unit& u) const { const int zz = u.z & 3; return (zz == 0 ? A0 : (zz == 1 ? A1 : A2)) + (size_t)u.pm * tstepA; }
  __device__ __forceinline__ const char* bptr(const Unit& u) const { return Bt + ((size_t)(u.z & 3) * 4 + u.pn) * tstepB; }
};
struct SchedOut {
  const char* M; const char* Mc; const char* Bt; int G, c, nctx; size_t tstep;
  __device__ __forceinline__ bool next(int i, Unit& u) const {
    const int nl = c < 256 ? (256 - c + G - 1) / G : 0;
    if (i < nl) { const int t0 = i * G + c, tile = (G == 256) ? ((t0 & 7) * 32 + (t0 >> 3)) : t0; u.pm = tile >> 2; u.pn = tile & 3; u.z = 0; return true; }
    const int j = (i - nl) * G + c; if (j >= nctx) return false;
    const int tile = j / 3; u.pm = 64 + (tile >> 2); u.pn = tile & 3; u.z = 4 + (j - tile * 3); return true; }
  __device__ __forceinline__ const char* aptr(const Unit& u) const { return u.z < 4 ? M + (size_t)u.pm * tstep : Mc + ((size_t)(u.z & 3) * 4 + (u.pm - 64)) * tstep; }
  __device__ __forceinline__ const char* bptr(const Unit& u) const { return Bt + (size_t)u.pn * tstep; }
};

struct FStoreBf16 { bf16_t* O; int ldc;
  __device__ __forceinline__ void operator()(const Unit&, int row, int col, f32x4 v0, f32x4 v1) const {
    u32x4 w; w[0] = cvt_pk_bf16(v0[0], v0[1]); w[1] = cvt_pk_bf16(v0[2], v0[3]); w[2] = cvt_pk_bf16(v1[0], v1[1]); w[3] = cvt_pk_bf16(v1[2], v1[3]);
    *(u32x4*)(O + (size_t)row * ldc + col) = w; } };
struct FStoreKV { bf16_t* Kb; bf16_t* Vb;
  __device__ __forceinline__ void operator()(const Unit&, int row, int col, f32x4 v0, f32x4 v1) const {
    u32x4 w; w[0] = cvt_pk_bf16(v0[0], v0[1]); w[1] = cvt_pk_bf16(v0[2], v0[3]); w[2] = cvt_pk_bf16(v1[0], v1[1]); w[3] = cvt_pk_bf16(v1[2], v1[3]);
    const int h = col >> 8, j = col & 255;
    bf16_t* dst = (j < 128) ? (Kb + (size_t)row * LDK + h * 192 + j) : (Vb + (size_t)row * LDV + h * 128 + (j - 128));
    *(u32x4*)dst = w; } };
struct FMerge { const bf16_t* U; bf16_t* Mo; bf16_t* Mc;
  __device__ __forceinline__ void operator()(const Unit& u, int row, int col, f32x4 v0, f32x4 v1) const {
    const int zz = u.z & 3;
    const u32x4 gw = *(const u32x4*)(U + (size_t)row * LDU + C_GA + zz * 1024 + col);
    float g[8]; unpack8(gw, g);
    float r[8];
#pragma unroll
    for (int j = 0; j < 4; ++j) { r[j] = sigmf(g[j]) * v0[j]; r[4 + j] = sigmf(g[4 + j]) * v1[j]; }
    if (u.z >= 4) { *(u32x4*)(Mc + ((size_t)zz * 1024 + (row - NLAT)) * 1024 + col) = pack8(r); return; }
    bf16_t* mp = Mo + (size_t)row * 1024 + col;
    if (u.z != 0) { const u32x4 ow = *(const u32x4*)mp; float o[8]; unpack8(ow, o);
#pragma unroll
      for (int j = 0; j < 8; ++j) r[j] += o[j]; }
    *(u32x4*)mp = pack8(r); } };
struct FOut { const float* xlat; float* olat; float* pctx; const float* mod; int lidx; bool dry;
  __device__ __forceinline__ void operator()(const Unit& u, int row, int col, f32x4 v0, f32x4 v1) const {
    if (row < NLAT) {
      const float* src = xlat + (size_t)row * 1024 + col; float* dst = olat + (size_t)row * 1024 + col;
      const float* gp = mod + (row >> 12) * 3072 + 2048 + col;
      const f32x4 g0 = *(const f32x4*)gp, g1 = *(const f32x4*)(gp + 4), x0 = *(const f32x4*)src, x1 = *(const f32x4*)(src + 4);
      if (!dry) { *(f32x4*)dst = x0 + g0 * v0; *(f32x4*)(dst + 4) = x1 + g1 * v1; }
    } else {
      float* dst = pctx + ((size_t)(u.z & 3) * 1024 + (row - NLAT)) * 1024 + col; const float* gp = mod + 4 * 3072 + 2048 + col;
      const f32x4 g0 = *(const f32x4*)gp, g1 = *(const f32x4*)(gp + 4);
      *(f32x4*)dst = g0 * v0; *(f32x4*)(dst + 4) = g1 * v1;
    } } };

__device__ __forceinline__ void phase_mod(const Params& p, unsigned char* lds) {
  float* sc = (float*)lds;
  const float* cin = p.in[1]; const float* cctx = p.in[3]; const float* wmod = p.in[4]; const float* bmod = p.in[5];
  float* mod = (float*)(p.ws + WS_MOD);
  const int tid = otid();
#ifdef LDS_PROBE
  { unsigned* fl = (unsigned*)(p.ws + WS_ROPE + 8192); unsigned bad = 0;
    for (int rep = 0; rep < 3; ++rep) { const int off = rep == 0 ? 61440 : (rep == 1 ? 100000 : 145408);
      __syncthreads();
      *(unsigned*)(lds + off + tid * 4) = 0x12340000u + tid * 7 + rep;
      __syncthreads();
      const int o = (tid + 77) & 511;
      if (*(unsigned*)(lds + off + o * 4) != 0x12340000u + o * 7 + rep) bad |= (1u << rep);
    }
    if (bad) atomicOr(fl, bad); }
#endif
  for (int it = blockIdx.x; it < DEPTH * 12 * 16; it += gridDim.x) {
    const int kb = it & 15, nb = (it >> 4) % 12, l = it / 192;
    __syncthreads();
    if (tid < 320) { const int bb = tid >> 6, kk = tid & 63; const float c = bb < 4 ? cin[bb * 1024 + kb * 64 + kk] : cctx[kb * 64 + kk]; sc[tid] = siluf(c); }
    __syncthreads();
    const int n = nb * 256 + (tid & 255), kh = tid >> 8;
    const float* w = wmod + ((size_t)l * 1024 + kb * 64 + kh * 32) * 3072 + n;
    float a0 = 0, a1 = 0, a2 = 0, a3 = 0, a4 = 0;
#pragma unroll 8
    for (int kk = 0; kk < 32; ++kk) { const float wv = w[(size_t)kk * 3072]; const int ki = kh * 32 + kk;
      a0 += sc[ki] * wv; a1 += sc[64 + ki] * wv; a2 += sc[128 + ki] * wv; a3 += sc[192 + ki] * wv; a4 += sc[256 + ki] * wv; }
    if (kb == 0 && kh == 0) { const float bv = bmod[l * 3072 + n]; a0 += bv; a1 += bv; a2 += bv; a3 += bv; a4 += bv; }
    float* m = (float*)(p.ws + WS_K) + (size_t)(kb * 2 + kh) * (DEPTH * 5 * 3072) + (size_t)l * 5 * 3072 + n;
    m[0] = a0; m[3072] = a1; m[2 * 3072] = a2; m[3 * 3072] = a3; m[4 * 3072] = a4;
  }
  if (blockIdx.x == gridDim.x - 1) {
    float* rope = (float*)(p.ws + WS_ROPE);
    for (int i = tid; i < 1024; i += 512) { const int pos = i >> 4, fi = i & 15;
      const float f = exp2f(-(float)fi * (13.287712379549449f / 16.f));
      const float ang = (float)pos * f; const float rev = __builtin_amdgcn_fractf(ang * 0.15915494309189535f);
      rope[2 * i] = __builtin_amdgcn_cosf(rev); rope[2 * i + 1] = __builtin_amdgcn_sinf(rev); }
  }
}

__device__ __forceinline__ void transpose_tile(const float* src, int K, int N, bf16_t* dst, int Kpad, int n0, int k0, float* tile, int tid) {
  __syncthreads();
#pragma unroll
  for (int hh = 0; hh < 2; ++hh) { const int kl = (tid >> 4) + hh * 32, nl = (tid & 15) * 4; const int k = k0 + kl, n = n0 + nl;
    f32x4 v = {0.f, 0.f, 0.f, 0.f};
    if (k < K && n < N) v = *(const f32x4*)(src + (size_t)k * N + n);
    float* t = tile + kl * 65 + nl; t[0] = v[0]; t[1] = v[1]; t[2] = v[2]; t[3] = v[3]; }
  __syncthreads();
  const int nl = tid >> 3, kl = (tid & 7) * 8; float f[8];
#pragma unroll
  for (int j = 0; j < 8; ++j) f[j] = tile[(kl + j) * 65 + nl];
  *(u32x4*)(dst + (size_t)(n0 + nl) * Kpad + k0 + kl) = pack8(f);
}
__device__ __forceinline__ void convert_range(const Params& p, int l, unsigned char* lds, int lo, int hi, int widx, int wcount) {
  float* tile = (float*)lds; const int tid0 = otid();
  for (int it = lo + widx; it < hi; it += wcount) {
    const float* src; bf16_t* dst; int K, N, Kpad, nkt, t;
    if (it < 3008) { t = it; src = p.in[7] + (size_t)l * 1024 * IN_DIM; K = 1024; N = IN_DIM; Kpad = 1024; nkt = 16; dst = (bf16_t*)(p.ws + WS_WIN); }
    else if (it < 3152) { t = it - 3008; src = p.in[16] + (size_t)l * 384 * 1536; K = 384; N = 1536; Kpad = 384; nkt = 6; dst = (bf16_t*)(p.ws + WS_WQ); }
    else if (it < 3280) { t = it - 3152; src = p.in[17] + (size_t)l * 128 * 2048; K = 128; N = 2048; Kpad = 256; nkt = 4; dst = (bf16_t*)(p.ws + WS_WKV); }
    else if (it < 4048) { t = it - 3280; const int br = t >> 8; t &= 255; src = p.in[20 + br] + (size_t)l * 1024 * 1024; K = 1024; N = 1024; Kpad = 1024; nkt = 16; dst = (bf16_t*)(p.ws + WS_WBR) + (size_t)br * 1024 * 1024; }
    else { t = it - 4048; src = p.in[23] + (size_t)l * 1024 * 1024; K = 1024; N = 1024; Kpad = 1024; nkt = 16; dst = (bf16_t*)(p.ws + WS_WOUT); }
    const int kt = t % nkt, ntile = t / nkt;
    transpose_tile(src, K, N, dst, Kpad, ntile * 64, kt * 64, tile, tid0);
  }
}
__device__ __forceinline__ void phase_norm_convert(const Params& p, int l, unsigned char* lds) {
  convert_range(p, l, lds, (l == 0 || gridDim.x <= 48) ? 0 : 4048, 4304, blockIdx.x, gridDim.x);
  const int tid0 = otid();
  const int wid = tid0 >> 6, lane = tid0 & 63;
  const float* xlat = l == 0 ? p.in[0] : p.out; const float* xctx = l == 0 ? p.in[2] : (const float*)(p.ws + WS_CTX);
  const float* ng = p.in[6] + l * 1024; const float* mod = (const float*)(p.ws + WS_MOD) + (size_t)l * 5 * 3072;
  bf16_t* H = (bf16_t*)(p.ws + WS_H);
  for (int r = blockIdx.x * 8 + wid; r < NR; r += gridDim.x * 8) {
    const float* xr = r < NLAT ? xlat + (size_t)r * 1024 : xctx + (size_t)(r - NLAT) * 1024; const int bb = r < NLAT ? (r >> 12) : 4;
    f32x4 v[4]; float ss = 0.f;
#pragma unroll
    for (int i = 0; i < 4; ++i) { v[i] = *(const f32x4*)(xr + i * 256 + lane * 4); ss += v[i][0] * v[i][0] + v[i][1] * v[i][1] + v[i][2] * v[i][2] + v[i][3] * v[i][3]; }
    if (r >= NLAT) {
      if (l > 0) { const float* pc = (const float*)(p.ws + WS_Q) + (size_t)(r - NLAT) * 1024;
#pragma unroll
        for (int i = 0; i < 4; ++i) { const int cc = i * 256 + lane * 4;
          v[i] = ((v[i] + *(const f32x4*)(pc + cc)) + *(const f32x4*)(pc + (size_t)1024 * 1024 + cc)) + *(const f32x4*)(pc + (size_t)2 * 1024 * 1024 + cc); }
        ss = 0.f;
#pragma unroll
        for (int i = 0; i < 4; ++i) ss += v[i][0] * v[i][0] + v[i][1] * v[i][1] + v[i][2] * v[i][2] + v[i][3] * v[i][3]; }
#pragma unroll
      for (int i = 0; i < 4; ++i) *(f32x4*)((float*)(p.ws + WS_CTX) + (size_t)(r - NLAT) * 1024 + i * 256 + lane * 4) = v[i]; }
    ss = wave_sum(ss); const float rstd = rsqrtf(ss * (1.f / 1024.f) + EPS);
#pragma unroll
    for (int i = 0; i < 4; ++i) { const int c = i * 256 + lane * 4;
      const f32x4 g = *(const f32x4*)(ng + c), sh = *(const f32x4*)(mod + bb * 3072 + c), scl = *(const f32x4*)(mod + bb * 3072 + 1024 + c);
      f32x4 y = v[i] * rstd * g; y = y * (scl + 1.f) + sh;
      u32x2 w; w[0] = cvt_pk_bf16(y[0], y[1]); w[1] = cvt_pk_bf16(y[2], y[3]);
      *(u32x2*)(H + (size_t)r * 1024 + c) = w; }
  }
}

__device__ __forceinline__ void phase_prep(const Params& p, int l, bool dry = false) {
  const int tid0 = otid(); const int wid = tid0 >> 6, lane = tid0 & 63;
  bf16_t* U = (bf16_t*)(p.ws + WS_U); bf16_t* YA = (bf16_t*)(p.ws + WS_YA);
  const float* cw = p.in[8] + (size_t)l * 3 * 1024; const float* gq = p.in[14] + l * 384; const float* gkv = p.in[15] + l * 128;
  const int c0 = lane * 16;
  float w0[16], w1[16], w2[16];
#pragma unroll
  for (int j = 0; j < 16; ++j) { w0[j] = cw[c0 + j]; w1[j] = cw[1024 + c0 + j]; w2[j] = cw[2048 + c0 + j]; }
  const bool isq = lane < 48; const int cn = isq ? C_CQ + lane * 8 : C_CKV + (lane - 48) * 8;
  float gn[8];
#pragma unroll
  for (int j = 0; j < 8; ++j) gn[j] = isq ? gq[lane * 8 + j] : gkv[(lane - 48) * 8 + j];
  const int G_ = (int)gridDim.x, c_ = (int)blockIdx.x; const bool bal_ = (G_ == 256), lite_ = bal_ && c_ < 64;
  const int g0_ = !bal_ ? c_ : (lite_ ? c_ : 384 + (c_ - 64)), gs_ = !bal_ ? G_ : (lite_ ? 64 : 192), ge_ = lite_ ? 384 : NR / 8;
  for (int g_ = g0_; g_ < ge_; g_ += gs_) { const int r = g_ * 8 + wid;
    const int spos = r < NLAT ? (r & 4095) : ((r - NLAT) & 255), slen = r < NLAT ? 4096 : 256;
    const bool hp = spos > 0, hn = spos < slen - 1;
    bf16_t* ur = U + (size_t)r * LDU; const bf16_t* up = hp ? ur - LDU : ur; const bf16_t* un = hn ? ur + LDU : ur;
    const float fp = hp ? 1.f : 0.f, fn = hn ? 1.f : 0.f;
    const u32x4 lav0 = *(const u32x4*)(ur + C_AV + c0), lav1 = *(const u32x4*)(ur + C_AV + c0 + 8), lac0 = *(const u32x4*)(ur + C_AC + c0), lac1 = *(const u32x4*)(ur + C_AC + c0 + 8);
    const u32x4 pav0 = *(const u32x4*)(up + C_AV + c0), pav1 = *(const u32x4*)(up + C_AV + c0 + 8), pac0 = *(const u32x4*)(up + C_AC + c0), pac1 = *(const u32x4*)(up + C_AC + c0 + 8);
    const u32x4 nav0 = *(const u32x4*)(un + C_AV + c0), nav1 = *(const u32x4*)(un + C_AV + c0 + 8), nac0 = *(const u32x4*)(un + C_AC + c0), nac1 = *(const u32x4*)(un + C_AC + c0 + 8);
    const u32x4 lab0 = *(const u32x4*)(ur + C_AB + c0), lab1 = *(const u32x4*)(ur + C_AB + c0 + 8), laz0 = *(const u32x4*)(ur + C_AZ + c0), laz1 = *(const u32x4*)(ur + C_AZ + c0 + 8);
    const u32x4 lcn = *(const u32x4*)(ur + cn);
    float a[16], cc[16], y[16], t0[16], t1[16];
    unpack8(lav0, a); unpack8(lav1, a + 8); unpack8(lac0, cc); unpack8(lac1, cc + 8);
#pragma unroll
    for (int j = 0; j < 16; ++j) y[j] = w1[j] * a[j] * cc[j];
    unpack8(pav0, t0); unpack8(pav1, t0 + 8); unpack8(pac0, t1); unpack8(pac1, t1 + 8);
#pragma unroll
    for (int j = 0; j < 16; ++j) y[j] += fp * w0[j] * t0[j] * t1[j];
    unpack8(nav0, t0); unpack8(nav1, t0 + 8); unpack8(nac0, t1); unpack8(nac1, t1 + 8);
#pragma unroll
    for (int j = 0; j < 16; ++j) y[j] += fn * w2[j] * t0[j] * t1[j];
    unpack8(lab0, t0); unpack8(lab1, t0 + 8); unpack8(laz0, t1); unpack8(laz1, t1 + 8);
#pragma unroll
    for (int j = 0; j < 16; ++j) y[j] = t0[j] * y[j] * siluf(t1[j]);
    *(u32x4*)(YA + (size_t)r * 1024 + c0) = pack8(y); *(u32x4*)(YA + (size_t)r * 1024 + c0 + 8) = pack8(y + 8);
    { float x[8]; unpack8(lcn, x);
      float ss = 0.f;
#pragma unroll
      for (int j = 0; j < 8; ++j) ss += x[j] * x[j];
      const float sq = wave_sum(isq ? ss : 0.f), sk = wave_sum(isq ? 0.f : ss);
      const float rstd = isq ? rsqrtf(sq * (1.f / 384.f) + EPS) : rsqrtf(sk * (1.f / 128.f) + EPS);
#pragma unroll
      for (int j = 0; j < 8; ++j) x[j] = x[j] * rstd * gn[j];
      *(u32x4*)((bf16_t*)(p.ws + WS_CN) + (size_t)r * 512 + (isq ? lane * 8 : 384 + (lane - 48) * 8)) = pack8(x); }
  }
}

__device__ __forceinline__ int gla_row(int b, int dir, int n, int i) {
  const int tau = n * 64 + i;
  if (n < 4) { const int j = dir ? 255 - tau : tau; return NLAT + b * 256 + j; }
  const int tp = tau - 256; const int t = dir ? 4095 - tp : tp; return b * 4096 + t;
}
__device__ __forceinline__ void phase_gla_intra(const Params& p, int l, unsigned char* lds, int c, int G) {
  const int tid = otid(), wid = tid >> 6, lane = tid & 63, fr = lane & 15, fq = lane >> 4;
  const int h = c & 3;
  bf16_t* U = (bf16_t*)(p.ws + WS_U);
  float* Wl = (float*)lds;
  float* Bl = Wl + 4096;
  unsigned char* QdF = lds + 17408;
  unsigned char* KiF = QdF + 17408; unsigned char* QdB = KiF + 17408; unsigned char* KiB = QdB + 17408;
  unsigned char* Vt = KiB + 17408;
  unsigned char* Att = Vt + 36864;
  const int cq = C_BQ + h * 128 + wid * 16, ck = C_BK + h * 128 + wid * 16, cv = C_BV + h * 256 + wid * 32;
  const int qstep = G >> 2;
  int qi = c >> 2;
  u32x4 q0, q1, k0, k1, a0, a1, e0, e1, v0, v1, v2, v3;
#define G1_ROW(Q, i) (((Q) % 68) < 4 ? NLAT + ((Q) / 68) * 256 + ((Q) % 68) * 64 + (i) : ((Q) / 68) * 4096 + (((Q) % 68) - 4) * 64 + (i))
#define G1_LOAD(Q) do { const bf16_t* ur = U + (size_t)G1_ROW(Q, lane) * LDU; \
    q0 = *(const u32x4*)(ur + cq); q1 = *(const u32x4*)(ur + cq + 8); k0 = *(const u32x4*)(ur + ck); k1 = *(const u32x4*)(ur + ck + 8); \
    a0 = *(const u32x4*)(ur + C_BAF); a1 = *(const u32x4*)(ur + C_BAF + 8); e0 = *(const u32x4*)(ur + C_BAB); e1 = *(const u32x4*)(ur + C_BAB + 8); \
    v0 = *(const u32x4*)(ur + cv); v1 = *(const u32x4*)(ur + cv + 8); v2 = *(const u32x4*)(ur + cv + 16); v3 = *(const u32x4*)(ur + cv + 24); } while (0)
  if (qi < 272) G1_LOAD(qi);
  __syncthreads();
  for (int i = tid; i < 4096; i += 512) { const int d_ = i >> 11, j_ = i & 2047; Wl[i] = (p.in[d_ ? 11 : 9] + (size_t)l * 16 * 512 + h * 128)[(j_ >> 7) * 512 + (j_ & 127)]; }
  if (tid < 256) Bl[tid] = (p.in[(tid >> 7) ? 12 : 10] + l * 512 + h * 128)[tid & 127];
  for (; qi < 272; qi += qstep) {
  const int b = qi / 68, pc = qi - b * 68, bh = b * 4 + h;
  const int row = G1_ROW(qi, lane);
  const int nF = pc, nB = pc < 4 ? 3 - pc : 71 - pc;
  __syncthreads();
  {
#define VTW(V, base) do { _Pragma("unroll") for (int ee = 0; ee < 4; ++ee) { \
      *(bf16_t*)(Vt + (wid * 32 + (base) + 2 * ee) * 144 + lane * 2) = (bf16_t)((V)[ee] & 0xffffu); *(bf16_t*)(Vt + (wid * 32 + (base) + 2 * ee + 1) * 144 + lane * 2) = (bf16_t)((V)[ee] >> 16); } } while (0)
    VTW(v0, 0); VTW(v1, 8); VTW(v2, 16); VTW(v3, 24);
#undef VTW
    float qf[16], kf[16];
    unpack8(q0, qf); unpack8(q1, qf + 8); unpack8(k0, kf); unpack8(k1, kf + 8);
#pragma unroll 1
    for (int dir = 0; dir < 2; ++dir) {
      float av[16], la[16];
      if (dir == 0) { unpack8(a0, av); unpack8(a1, av + 8); } else { unpack8(e0, av); unpack8(e1, av + 8); }
      const float* Wd = Wl + dir * 2048;
#pragma unroll
      for (int dd = 0; dd < 16; ++dd) la[dd] = Bl[dir * 128 + wid * 16 + dd];
#pragma unroll
      for (int r = 0; r < 16; ++r) {
        const f32x4 w0 = *(const f32x4*)(Wd + r * 128 + wid * 16), w1 = *(const f32x4*)(Wd + r * 128 + wid * 16 + 4), w2 = *(const f32x4*)(Wd + r * 128 + wid * 16 + 8), w3 = *(const f32x4*)(Wd + r * 128 + wid * 16 + 12);
#pragma unroll
        for (int j = 0; j < 4; ++j) { la[j] += av[r] * w0[j]; la[4 + j] += av[r] * w1[j]; la[8 + j] += av[r] * w2[j]; la[12 + j] += av[r] * w3[j]; }
      }
#pragma unroll
      for (int dd = 0; dd < 16; ++dd) { const float z = la[dd]; la[dd] = (fminf(z, 0.f) - __logf(1.f + __expf(-fabsf(z)))) * 0.0625f; }
      if (dir == 0) {
#pragma unroll
        for (int off = 1; off < 64; off <<= 1) {
#pragma unroll
          for (int dd = 0; dd < 16; ++dd) { const float t = __shfl_up(la[dd], off, 64); if (lane >= off) la[dd] += t; }
        }
      } else {
#pragma unroll
        for (int off = 1; off < 64; off <<= 1) {
#pragma unroll
          for (int dd = 0; dd < 16; ++dd) { const float t = __shfl_down(la[dd], off, 64); if (lane + off < 64) la[dd] += t; }
        }
      }
      const int nv = dir ? nB : nF, jv = dir ? 63 - lane : lane;
      bf16_t* ket = (bf16_t*)(p.ws + WS_KET) + ((size_t)((dir * 16 + bh) * 68 + nv)) * 8192 + (size_t)(wid * 16) * 64 + jv;
      float* gd = (float*)(p.ws + WS_GD) + ((size_t)((dir * 16 + bh) * 68 + nv)) * 128 + wid * 16;
      float qd[16], ki[16];
#pragma unroll
      for (int dd = 0; dd < 16; ++dd) {
        const float bl = __shfl(la[dd], dir ? 0 : 63, 64);
        qd[dd] = qf[dd] * 0.08838834764831845f * __expf(la[dd]);
        ki[dd] = kf[dd] * __expf(-la[dd]);
        ket[dd * 64] = f2bf(kf[dd] * __expf(bl - la[dd]));
        if (lane == dd) gd[dd] = __expf(bl);
      }
      unsigned char* Qd = dir ? QdB : QdF; unsigned char* Ki = dir ? KiB : KiF;
      const u32x4 qa = pack8(qd), qb = pack8(qd + 8);
      *(u32x4*)(Qd + lane * 272 + wid * 32) = qa; *(u32x4*)(Qd + lane * 272 + wid * 32 + 16) = qb;
      bf16_t* qdg = (bf16_t*)(p.ws + WS_QD) + ((size_t)dir * NR + row) * 512 + h * 128 + wid * 16;
      *(u32x4*)qdg = qa; *(u32x4*)(qdg + 8) = qb;
      *(u32x4*)(Ki + lane * 272 + wid * 32) = pack8(ki); *(u32x4*)(Ki + lane * 272 + wid * 32 + 16) = pack8(ki + 8);
    }
  }
  if (qi + qstep < 272) G1_LOAD(qi + qstep);
  __syncthreads();
  {
    const int ti = wid >> 1, tj0 = (wid & 1) * 2;
    f32x4 c0 = {0.f, 0.f, 0.f, 0.f}, c1 = {0.f, 0.f, 0.f, 0.f}, d0 = {0.f, 0.f, 0.f, 0.f}, d1 = {0.f, 0.f, 0.f, 0.f};
#pragma unroll
    for (int ks = 0; ks < 4; ++ks) {
      const int ko = (ks * 32 + 8 * fq) * 2;
      const bf16x8 A = *(const bf16x8*)(QdF + (16 * ti + fr) * 272 + ko);
      const bf16x8 B0 = *(const bf16x8*)(KiF + (16 * tj0 + fr) * 272 + ko), B1 = *(const bf16x8*)(KiF + (16 * (tj0 + 1) + fr) * 272 + ko);
      c0 = __builtin_amdgcn_mfma_f32_16x16x32_bf16(A, B0, c0, 0, 0, 0);
      c1 = __builtin_amdgcn_mfma_f32_16x16x32_bf16(A, B1, c1, 0, 0, 0);
      const bf16x8 A2 = *(const bf16x8*)(QdB + (16 * ti + fr) * 272 + ko);
      const bf16x8 E0 = *(const bf16x8*)(KiB + (16 * tj0 + fr) * 272 + ko), E1 = *(const bf16x8*)(KiB + (16 * (tj0 + 1) + fr) * 272 + ko);
      d0 = __builtin_amdgcn_mfma_f32_16x16x32_bf16(A2, E0, d0, 0, 0, 0);
      d1 = __builtin_amdgcn_mfma_f32_16x16x32_bf16(A2, E1, d1, 0, 0, 0);
    }
#pragma unroll
    for (int r = 0; r < 4; ++r) { const int i = 16 * ti + 4 * fq + r, j0 = 16 * tj0 + fr, j1 = j0 + 16;
      *(bf16_t*)(Att + i * 144 + j0 * 2) = f2bf((j0 <= i ? c0[r] : 0.f) + (j0 >= i ? d0[r] : 0.f));
      *(bf16_t*)(Att + i * 144 + j1 * 2) = f2bf((j1 <= i ? c1[r] : 0.f) + (j1 >= i ? d1[r] : 0.f)); }
  }
  __syncthreads();
  {
    bf16_t* Ho = (bf16_t*)(p.ws + WS_H);
    const int ti = wid >> 1, te0 = (wid & 1) * 8;
    const bf16x8 A0 = *(const bf16x8*)(Att + (16 * ti + fr) * 144 + (8 * fq) * 2), A1 = *(const bf16x8*)(Att + (16 * ti + fr) * 144 + (32 + 8 * fq) * 2);
#pragma unroll
    for (int t = 0; t < 8; ++t) {
      const bf16x8 B0 = *(const bf16x8*)(Vt + (16 * (te0 + t) + fr) * 144 + (8 * fq) * 2), B1 = *(const bf16x8*)(Vt + (16 * (te0 + t) + fr) * 144 + (32 + 8 * fq) * 2);
      f32x4 o = {0.f, 0.f, 0.f, 0.f};
      o = __builtin_amdgcn_mfma_f32_16x16x32_bf16(A0, B0, o, 0, 0, 0);
      o = __builtin_amdgcn_mfma_f32_16x16x32_bf16(A1, B1, o, 0, 0, 0);
#pragma unroll
      for (int r = 0; r < 4; ++r) Ho[(size_t)G1_ROW(qi, 16 * ti + 4 * fq + r) * 1024 + h * 256 + 16 * (te0 + t) + fr] = f2bf(o[r]);
    }
  }
  }
#undef G1_LOAD
#undef G1_ROW
}

__device__ __forceinline__ void phase_gla_inter(const Params& p, int l, unsigned char* lds, int item) {
  const int tid = otid(), wid = tid >> 6, lane = tid & 63, fr = lane & 15, fq = lane >> 4;
  const int slot_ = item >> 3, comb_ = (item & 7) * 4 + (slot_ >> 3);
  const int vs = slot_ & 7, bh = comb_ & 15, dir = comb_ >> 4, h = bh & 3, b = bh >> 2;
  bf16_t* U = (bf16_t*)(p.ws + WS_U);
  unsigned char* St = lds + 2 * 40960;
  const bf16_t* QD = (const bf16_t*)(p.ws + WS_QD) + (size_t)dir * NR * 512 + h * 128;
  const bf16_t* KET = (const bf16_t*)(p.ws + WS_KET) + (size_t)((dir * 16 + bh) * 68) * 8192;
  const float* GD = (const float*)(p.ws + WS_GD) + (size_t)((dir * 16 + bh) * 68) * 128;
  const int cv = C_BV + h * 256 + vs * 32, co = (dir ? C_BQ : C_AC) + h * 256 + vs * 32;
  __syncthreads();
  for (int i = tid; i < 2 * 8704 / 4; i += 512) ((unsigned*)St)[i] = 0u;
  f32x4 S[2];
  S[0] = (f32x4){0.f, 0.f, 0.f, 0.f}; S[1] = S[0];
  struct G2Regs { u32x4 q0, q1, k0, k1, vv; float gg; };
  const int qi = tid >> 3, qp = (tid & 7) * 8;
  const int kd = tid >> 2, kp = (tid & 3) * 8;
  const int vj = tid >> 2, ve = (tid & 3) * 8;
#define G2_LOAD(R, n) do { const bf16_t* qr_ = QD + (size_t)gla_row(b, dir, (n), qi) * 512; R.q0 = *(const u32x4*)(qr_ + qp); R.q1 = *(const u32x4*)(qr_ + 64 + qp); \
    const bf16_t* kr_ = KET + (size_t)(n) * 8192 + kd * 64; R.k0 = *(const u32x4*)(kr_ + kp); R.k1 = *(const u32x4*)(kr_ + 32 + kp); \
    if (tid < 256) R.vv = *(const u32x4*)(U + (size_t)gla_row(b, dir, (n), vj) * LDU + cv + ve); \
    if (tid < 128) R.gg = GD[(size_t)(n) * 128 + tid]; } while (0)
  G2Regs RA, RB;
  G2_LOAD(RA, 0); G2_LOAD(RB, 1);
  auto step = [&](G2Regs& R, const int n, const int cb) __attribute__((always_inline)) {
    unsigned char* Qd = lds + cb * 40960; unsigned char* Ket = Qd + 17408; unsigned char* Vt = Ket + 18432; float* Gd = (float*)(Vt + 4608);
    unsigned char* Sc = St + cb * 8704; unsigned char* Sn = St + (cb ^ 1) * 8704;
    *(u32x4*)(Qd + qi * 272 + qp * 2) = R.q0; *(u32x4*)(Qd + qi * 272 + 128 + qp * 2) = R.q1;
    *(u32x4*)(Ket + kd * 144 + kp * 2) = R.k0; *(u32x4*)(Ket + kd * 144 + 64 + kp * 2) = R.k1;
    if (tid < 256) {
#pragma unroll
      for (int ee = 0; ee < 4; ++ee) { *(bf16_t*)(Vt + (ve + 2 * ee) * 144 + vj * 2) = (bf16_t)(R.vv[ee] & 0xffffu); *(bf16_t*)(Vt + (ve + 2 * ee + 1) * 144 + vj * 2) = (bf16_t)(R.vv[ee] >> 16); }
    }
    if (tid < 128) Gd[tid] = R.gg;
    if (n + 2 < 68) G2_LOAD(R, n + 2);
    __syncthreads();
    {
      const int ti = wid >> 1, te = wid & 1;
      f32x4 o = {0.f, 0.f, 0.f, 0.f};
#pragma unroll
      for (int ks = 0; ks < 4; ++ks) {
        const bf16x8 A = *(const bf16x8*)(Qd + (16 * ti + fr) * 272 + (ks * 32 + 8 * fq) * 2);
        const bf16x8 Bs = *(const bf16x8*)(Sc + (16 * te + fr) * 272 + (ks * 32 + 8 * fq) * 2);
        o = __builtin_amdgcn_mfma_f32_16x16x32_bf16(A, Bs, o, 0, 0, 0);
      }
#pragma unroll
      for (int r = 0; r < 4; ++r) U[(size_t)gla_row(b, dir, n, 16 * ti + 4 * fq + r) * LDU + co + 16 * te + fr] = f2bf(o[r]);
      const f32x4 gv = *(const f32x4*)(Gd + wid * 16 + 4 * fq);
      S[0] = S[0] * gv; S[1] = S[1] * gv;
#pragma unroll
      for (int ks = 0; ks < 2; ++ks) {
        const bf16x8 A = *(const bf16x8*)(Ket + (16 * wid + fr) * 144 + (ks * 32 + 8 * fq) * 2);
        const bf16x8 B0 = *(const bf16x8*)(Vt + fr * 144 + (ks * 32 + 8 * fq) * 2), B1 = *(const bf16x8*)(Vt + (16 + fr) * 144 + (ks * 32 + 8 * fq) * 2);
        S[0] = __builtin_amdgcn_mfma_f32_16x16x32_bf16(A, B0, S[0], 0, 0, 0);
        S[1] = __builtin_amdgcn_mfma_f32_16x16x32_bf16(A, B1, S[1], 0, 0, 0);
      }
#pragma unroll
      for (int te2 = 0; te2 < 2; ++te2) { u32x2 w; w[0] = cvt_pk_bf16(S[te2][0], S[te2][1]); w[1] = cvt_pk_bf16(S[te2][2], S[te2][3]);
        *(u32x2*)(Sn + (16 * te2 + fr) * 272 + (16 * wid + 4 * fq) * 2) = w; }
    }
  };
  for (int n = 0; n < 68; n += 2) { step(RA, n, 0); step(RB, n + 1, 1); }
#undef G2_LOAD
  __syncthreads();
}

__device__ __forceinline__ void phase_qknorm_yb(const Params& p, int l, bool dry = false) {
  const int tid0 = otid(); const int wid = tid0 >> 6, lane = tid0 & 63;
  bf16_t* U = (bf16_t*)(p.ws + WS_U); bf16_t* Kb = (bf16_t*)(p.ws + WS_K); bf16_t* YB = (bf16_t*)(p.ws + WS_YB);
  const float* rope = (const float*)(p.ws + WS_ROPE);
  const float* kg = p.in[19] + l * 192; const float* gng = p.in[13] + l * 1024;
  const int hh = lane >> 3, s8 = lane & 7;
  const int c = lane * 16;
  float kgn[16], kgr[8], gg[16];
#pragma unroll
  for (int j = 0; j < 16; ++j) { kgn[j] = kg[s8 * 16 + j]; gg[j] = gng[c + j]; }
#pragma unroll
  for (int j = 0; j < 8; ++j) kgr[j] = kg[128 + s8 * 8 + j];
  const float sgn = (s8 & 2) ? 1.f : -1.f;
  for (int r = blockIdx.x * 8 + wid; r < NR; r += gridDim.x * 8) {
    const bool lat = r < NLAT; const int t = r & 4095;
    bf16_t* kp = Kb + (size_t)r * LDK + hh * 192; const bf16_t* ur = U + (size_t)r * LDU;
    const int pos = (s8 < 4) ? (t >> 6) : (t & 63); const float* rp = rope + (pos * 16 + (s8 & 1) * 8) * 2;
    const u32x4 lk0 = *(const u32x4*)(kp + s8 * 16), lk1 = *(const u32x4*)(kp + s8 * 16 + 8), lkr = *(const u32x4*)(ur + C_CKR + s8 * 8);
    const bf16_t* hr = (const bf16_t*)(p.ws + WS_H) + (size_t)r * 1024;
    const u32x4 o00 = *(const u32x4*)(hr + c), o01 = *(const u32x4*)(hr + c + 8);
    const u32x4 o20 = *(const u32x4*)(ur + C_AC + c), o21 = *(const u32x4*)(ur + C_AC + c + 8), o30 = *(const u32x4*)(ur + C_BQ + c), o31 = *(const u32x4*)(ur + C_BQ + c + 8);
    const u32x4 lz0 = *(const u32x4*)(ur + C_BZ + c), lz1 = *(const u32x4*)(ur + C_BZ + c + 8);
    f32x4 rc0 = {1.f, 0.f, 1.f, 0.f}, rc1 = rc0, rc2 = rc0, rc3 = rc0;
    if (lat) { rc0 = *(const f32x4*)rp; rc1 = *(const f32x4*)(rp + 4); rc2 = *(const f32x4*)(rp + 8); rc3 = *(const f32x4*)(rp + 12); }
    const float cs[8] = {rc0[0], rc0[2], rc1[0], rc1[2], rc2[0], rc2[2], rc3[0], rc3[2]}, sn[8] = {rc0[1], rc0[3], rc1[1], rc1[3], rc2[1], rc2[3], rc3[1], rc3[3]};
    { float x[16], kr[8];
      unpack8(lk0, x); unpack8(lk1, x + 8); unpack8(lkr, kr);
      float ss = 0.f;
#pragma unroll
      for (int j = 0; j < 16; ++j) ss += x[j] * x[j];
#pragma unroll
      for (int j = 0; j < 8; ++j) ss += kr[j] * kr[j];
      ss += __shfl_xor(ss, 1, 64); ss += __shfl_xor(ss, 2, 64); ss += __shfl_xor(ss, 4, 64);
      const float rstd = rsqrtf(ss * (1.f / 192.f) + EPS);
#pragma unroll
      for (int j = 0; j < 16; ++j) x[j] *= rstd * kgn[j];
#pragma unroll
      for (int j = 0; j < 8; ++j) kr[j] *= rstd * kgr[j];
      if (!dry) { *(u32x4*)(kp + s8 * 16) = pack8(x); *(u32x4*)(kp + s8 * 16 + 8) = pack8(x + 8); }
#pragma unroll
      for (int j = 0; j < 8; ++j) { const float pr = __shfl_xor(kr[j], 2, 64); x[j] = kr[j] * cs[j] + sgn * pr * sn[j]; }
      if (!dry) *(u32x4*)(kp + 128 + s8 * 8) = pack8(x);
    }
    { float of[16], ob[16];
      unpack8(o00, of); unpack8(o01, of + 8);
      unpack8(o20, ob); unpack8(o21, ob + 8);
#pragma unroll
      for (int j = 0; j < 16; ++j) of[j] += ob[j];
      unpack8(o30, ob); unpack8(o31, ob + 8);
      float ss = 0.f;
#pragma unroll
      for (int j = 0; j < 16; ++j) { of[j] += ob[j]; ss += of[j] * of[j]; }
#pragma unroll
      for (int m = 8; m >= 1; m >>= 1) ss += __shfl_xor(ss, m, 64);
      const float rstd = rsqrtf(ss * (1.f / 256.f) + EPS);
      unpack8(lz0, ob); unpack8(lz1, ob + 8);
#pragma unroll
      for (int j = 0; j < 16; ++j) of[j] = of[j] * rstd * gg[j] * siluf(ob[j]);
      bf16_t* yb = YB + (size_t)r * 1024 + c;
      *(u32x4*)yb = pack8(of); *(u32x4*)(yb + 8) = pack8(of + 8); }
  }
}

namespace att {
constexpr int KVBLK = 64;
constexpr float SCALE = 0.07216878364870322f;
constexpr float THR = 8.f;
constexpr int SHM_V = 64 * 128 * 2, SHM_K = 64 * 192 * 2;
#define KSWZ(row, colB) ((row) * 384 + ((colB) ^ (((row) & 7) << 4)))
#define SBAR() __builtin_amdgcn_sched_barrier(0)
__device__ __forceinline__ int crow(int r, int hi) { return (r & 3) + 8 * (r >> 2) + 4 * hi; }
__device__ __forceinline__ void partialSM(f32x16& p0, f32x16& p1, float& m_reg, float& mn, float& alpha) {
  constexpr float C = SCALE * 1.4426950408889634f;
  float pmax = p0[0];
#pragma unroll
  for (int r = 1; r < 16; ++r) pmax = fmaxf(pmax, p0[r]);
#pragma unroll
  for (int r = 0; r < 16; ++r) pmax = fmaxf(pmax, p1[r]);
  { auto rr = __builtin_amdgcn_permlane32_swap(__float_as_uint(pmax), __float_as_uint(pmax), false, false);
    pmax = fmaxf(__uint_as_float(rr[0]), __uint_as_float(rr[1])); }
  if (__builtin_expect(__all(pmax - m_reg <= THR / SCALE), 1)) { mn = m_reg; alpha = 1.f; }
  else { mn = fmaxf(m_reg, pmax); alpha = __builtin_amdgcn_exp2f((m_reg - mn) * C); m_reg = mn; }
  const float mnC = -mn * C;
#pragma unroll
  for (int r = 0; r < 16; ++r) p0[r] = fmaf(p0[r], C, mnC);
#pragma unroll
  for (int r = 0; r < 16; ++r) p1[r] = fmaf(p1[r], C, mnC);
#pragma unroll
  for (int r = 0; r < 16; ++r) p0[r] = __builtin_amdgcn_exp2f(p0[r]);
}
__device__ __forceinline__ void finishSM(f32x16& p0, f32x16& p1, float alpha, float& l_reg, bf16x8& pa0, bf16x8& pa1, bf16x8& pa2, bf16x8& pa3) {
#pragma unroll
  for (int r = 0; r < 16; ++r) p1[r] = __builtin_amdgcn_exp2f(p1[r]);
  float ps = 0;
#pragma unroll
  for (int r = 0; r < 16; ++r) ps += p0[r];
#pragma unroll
  for (int r = 0; r < 16; ++r) ps += p1[r];
  { auto rr = __builtin_amdgcn_permlane32_swap(__float_as_uint(ps), __float_as_uint(ps), false, false);
    ps = __uint_as_float(rr[0]) + __uint_as_float(rr[1]); }
  l_reg = l_reg * alpha + ps;
#define PK4(P, BASE, OUT) do { unsigned a0 = cvt_pk_bf16(P[BASE + 0], P[BASE + 1]), a1 = cvt_pk_bf16(P[BASE + 2], P[BASE + 3]);   \
    unsigned b0 = cvt_pk_bf16(P[BASE + 4], P[BASE + 5]), b1 = cvt_pk_bf16(P[BASE + 6], P[BASE + 7]);                              \
    auto r0 = __builtin_amdgcn_permlane32_swap(a0, b0, false, false); auto r1 = __builtin_amdgcn_permlane32_swap(a1, b1, false, false); \
    u32x4 w = {r0[0], r1[0], r0[1], r1[1]}; OUT = *reinterpret_cast<bf16x8*>(&w); } while (0)
  PK4(p0, 0, pa0); PK4(p0, 8, pa1); PK4(p1, 0, pa2); PK4(p1, 8, pa3);
#undef PK4
}
__device__ __forceinline__ void qkt(f32x16& p0, f32x16& p1, const unsigned char* Ks, const bf16x8* qr, int r32, int hi) {
  p0 = f32x16{}; p1 = f32x16{};
#pragma unroll
  for (int d0 = 0; d0 < 12; ++d0) { const int cb = (d0 * 16 + hi * 8) * 2;
    const bf16x8 b0 = *reinterpret_cast<const bf16x8*>(Ks + KSWZ(r32, cb));
    const bf16x8 b1 = *reinterpret_cast<const bf16x8*>(Ks + KSWZ(32 + r32, cb));
    p0 = __builtin_amdgcn_mfma_f32_32x32x16_bf16(b0, qr[d0], p0, 0, 0, 0);
    p1 = __builtin_amdgcn_mfma_f32_32x32x16_bf16(b1, qr[d0], p1, 0, 0, 0); }
}
__device__ __forceinline__ int v_st(int k, int c) { const int kk = (k & ~0xC) | ((k & 4) << 1) | ((k & 8) >> 1); return ((kk >> 3) * 4 + (c >> 5)) * 512 + ((kk & 7) * 32 + (c & 31)) * 2; }
__device__ __forceinline__ int v_rd_base(int lane) { return ((lane & 3) << 3) | (((lane >> 2) & 3) << 6) | (((lane >> 4) & 1) << 5) | (((lane >> 5) & 1) << 8); }
constexpr int v_rd_off(int d0, int ks, int half) { return d0 * 512 + ks * 4096 + half * 2048; }
template <int OFF> __device__ __forceinline__ s16x4 tr_read(int vb) {
  s16x4 r; asm volatile("ds_read_b64_tr_b16 %0, %1 offset:%2" : "=&v"(r) : "v"(vb), "i"(OFF) : "memory"); return r;
}
template <int D0> __device__ __forceinline__ void pv_one(f32x16& od, int vb, bf16x8 pa0, bf16x8 pa1, bf16x8 pa2, bf16x8 pa3) {
  const s16x4 l0 = tr_read<v_rd_off(D0, 0, 0)>(vb), h0 = tr_read<v_rd_off(D0, 0, 1)>(vb), l1 = tr_read<v_rd_off(D0, 1, 0)>(vb), h1 = tr_read<v_rd_off(D0, 1, 1)>(vb);
  const s16x4 l2 = tr_read<v_rd_off(D0, 2, 0)>(vb), h2 = tr_read<v_rd_off(D0, 2, 1)>(vb), l3 = tr_read<v_rd_off(D0, 3, 0)>(vb), h3 = tr_read<v_rd_off(D0, 3, 1)>(vb);
  asm volatile("s_waitcnt lgkmcnt(0)" ::: "memory"); SBAR();
#define PK(L, H) (bf16x8){L[0], L[1], L[2], L[3], H[0], H[1], H[2], H[3]}
  od = __builtin_amdgcn_mfma_f32_32x32x16_bf16(pa0, PK(l0, h0), od, 0, 0, 0);
  od = __builtin_amdgcn_mfma_f32_32x32x16_bf16(pa1, PK(l1, h1), od, 0, 0, 0);
  od = __builtin_amdgcn_mfma_f32_32x32x16_bf16(pa2, PK(l2, h2), od, 0, 0, 0);
  od = __builtin_amdgcn_mfma_f32_32x32x16_bf16(pa3, PK(l3, h3), od, 0, 0, 0);
#undef PK
}
__device__ __forceinline__ void pv_d0(f32x16* o, int vb, bf16x8 pa0, bf16x8 pa1, bf16x8 pa2, bf16x8 pa3) {
  pv_one<0>(o[0], vb, pa0, pa1, pa2, pa3); pv_one<1>(o[1], vb, pa0, pa1, pa2, pa3); pv_one<2>(o[2], vb, pa0, pa1, pa2, pa3); pv_one<3>(o[3], vb, pa0, pa1, pa2, pa3);
}
__device__ __forceinline__ void attn_body(const bf16_t* __restrict__ Qg, const bf16_t* __restrict__ Kg, const bf16_t* __restrict__ Vg, const bf16_t* __restrict__ U, bf16_t* __restrict__ Yc,
                                          int qrow0, int h, int klat0, int nlt, int kctx0, int nct, unsigned char* lds, bool dry, const float* __restrict__ qg, const float* __restrict__ rope, bool qlat) {
  const int tid = otid(), wid = tid >> 6, lane = tid & 63, r32 = lane & 31, hi = lane >> 5;
  unsigned char* V_lds = lds; unsigned char* K_lds = lds + 2 * SHM_V;
  float* wsf = (float*)(lds + 2 * SHM_V + 2 * SHM_K) + wid * 64; float* li_l = wsf; float* al_l = wsf + 32;
  float m_reg = -1e30f, l_reg = 0; f32x16 o[4] = {}; bf16x8 qr[12];
  const bf16_t* Qw = Qg + (size_t)(qrow0 + wid * 32 + r32) * LDQ + h * 192 + hi * 8;
  {
    u32x4 raw[12]; float ss = 0.f;
#pragma unroll
    for (int d0 = 0; d0 < 12; ++d0) { raw[d0] = *reinterpret_cast<const u32x4*>(Qw + d0 * 16); float f[8]; unpack8(raw[d0], f);
#pragma unroll
      for (int j = 0; j < 8; ++j) ss += f[j] * f[j]; }
    ss += __shfl_xor(ss, 32, 64);
    const float rstd = rsqrtf(ss * (1.f / 192.f) + EPS);
    float xa[8];
#pragma unroll
    for (int d0 = 0; d0 < 12; ++d0) {
      float f[8]; unpack8(raw[d0], f);
      const f32x4 g0 = *(const f32x4*)(qg + d0 * 16 + hi * 8), g1 = *(const f32x4*)(qg + d0 * 16 + hi * 8 + 4);
#pragma unroll
      for (int j = 0; j < 4; ++j) { f[j] *= rstd * g0[j]; f[4 + j] *= rstd * g1[j]; }
      if (d0 == 8 || d0 == 10) {
#pragma unroll
        for (int j = 0; j < 8; ++j) xa[j] = f[j];
      } else if (d0 == 9 || d0 == 11) {
        const int t = (qrow0 + wid * 32 + r32) & 4095; const int pos = (d0 == 9) ? (t >> 6) : (t & 63);
        const float* rp = rope + (pos * 16 + hi * 8) * 2;
        float lo[8];
#pragma unroll
        for (int j = 0; j < 8; ++j) { float cs = 1.f, sn = 0.f; if (qlat) { cs = rp[2 * j]; sn = rp[2 * j + 1]; }
          lo[j] = xa[j] * cs - f[j] * sn; f[j] = f[j] * cs + xa[j] * sn; }
        u32x4 w = pack8(lo); qr[d0 - 1] = *reinterpret_cast<bf16x8*>(&w);
      }
      if (d0 != 8 && d0 != 10) { u32x4 w = pack8(f); qr[d0] = *reinterpret_cast<bf16x8*>(&w); }
    }
  }
  const int sr = tid >> 4, sc = (tid & 15) * 8, vst0 = v_st(sr, sc), vst1 = v_st(32 + sr, sc);
  const int kr0 = tid / 24, kc0 = (tid % 24), kr1 = (tid + 512) / 24, kc1 = (tid + 512) % 24, kr2 = (tid + 1024) / 24, kc2 = (tid + 1024) % 24;
  const int vb0 = (int)(uintptr_t)V_lds + v_rd_base(lane);
  const int NT = nlt + nct;
  bf16x8 vs0, vs1, ks0, ks1, ks2;
#define TROW(t) ((t) < nlt ? klat0 + (t) * 64 : kctx0 + ((t) - nlt) * 64)
#define SLOAD(t) do { const int k0_ = TROW(t); vs0 = *reinterpret_cast<const bf16x8*>(Vg + (size_t)(k0_ + sr) * LDV + h * 128 + sc); vs1 = *reinterpret_cast<const bf16x8*>(Vg + (size_t)(k0_ + 32 + sr) * LDV + h * 128 + sc); \
    ks0 = *reinterpret_cast<const bf16x8*>(Kg + (size_t)(k0_ + kr0) * LDK + h * 192 + kc0 * 8); ks1 = *reinterpret_cast<const bf16x8*>(Kg + (size_t)(k0_ + kr1) * LDK + h * 192 + kc1 * 8); \
    ks2 = *reinterpret_cast<const bf16x8*>(Kg + (size_t)(k0_ + kr2) * LDK + h * 192 + kc2 * 8); } while (0)
#define SWRITE(b) do { *(bf16x8*)(V_lds + (b) * SHM_V + vst0) = vs0; *(bf16x8*)(V_lds + (b) * SHM_V + vst1) = vs1; \
    *(bf16x8*)(K_lds + (b) * SHM_K + KSWZ(kr0, kc0 * 16)) = ks0; *(bf16x8*)(K_lds + (b) * SHM_K + KSWZ(kr1, kc1 * 16)) = ks1; *(bf16x8*)(K_lds + (b) * SHM_K + KSWZ(kr2, kc2 * 16)) = ks2; } while (0)
#define SWAIT() asm volatile("s_waitcnt vmcnt(0)" ::: "memory")
#define RESC(a) do { if (__any((a) < 1.f)) { if (hi == 0) al_l[r32] = (a); asm volatile("s_waitcnt lgkmcnt(0)" ::: "memory"); \
    _Pragma("unroll") for (int d = 0; d < 4; ++d) _Pragma("unroll") for (int r = 0; r < 16; ++r) o[d][r] *= al_l[crow(r, hi)]; } } while (0)
  f32x16 p0, p1; float mn, al; bf16x8 pa0, pa1, pa2, pa3;
  SLOAD(0); SWAIT(); SWRITE(0); if (NT > 1) SLOAD(1);
  for (int j = 0; j < NT; ++j) {
    __syncthreads();
    if (j + 1 < NT) { SWAIT(); SWRITE((j + 1) & 1); }
    if (j + 2 < NT) SLOAD(j + 2);
    SBAR(); qkt(p0, p1, K_lds + (j & 1) * SHM_K, qr, r32, hi);
    partialSM(p0, p1, m_reg, mn, al);
    RESC(al);
    finishSM(p0, p1, al, l_reg, pa0, pa1, pa2, pa3); SBAR();
    pv_d0(o, vb0 + (j & 1) * SHM_V, pa0, pa1, pa2, pa3);
  }
  if (hi == 0) li_l[r32] = l_reg; asm volatile("s_waitcnt lgkmcnt(0)" ::: "memory");
  float rli[16];
#pragma unroll
  for (int r = 0; r < 16; ++r) rli[r] = __builtin_amdgcn_rcpf(li_l[crow(r, hi)]);
  __syncthreads();
  if (dry) return;
  unsigned char* ot = lds + wid * 8704;
#pragma unroll
  for (int r = 0; r < 16; ++r) { const int orow = crow(r, hi);
#pragma unroll
    for (int d0 = 0; d0 < 4; ++d0) *(bf16_t*)(ot + orow * 272 + (d0 * 32 + r32) * 2) = f2bf(o[d0][r] * rli[r]); }
  asm volatile("s_waitcnt lgkmcnt(0)" ::: "memory");
  const bf16_t* Ow = U + (size_t)(qrow0 + wid * 32) * LDU + C_CZ + h * 128;
  bf16_t* Yw = Yc + (size_t)(qrow0 + wid * 32) * 1024 + h * 128;
#pragma unroll
  for (int i = 0; i < 8; ++i) { const int ci = i * 64 + lane, orow = ci >> 4, c8 = (ci & 15) * 8;
    float ov[8], zv[8];
    unpack8(*(const u32x4*)(ot + orow * 272 + c8 * 2), ov); unpack8(*(const u32x4*)(Ow + (size_t)orow * LDU + c8), zv);
#pragma unroll
    for (int j = 0; j < 8; ++j) ov[j] *= siluf(zv[j]);
    *(u32x4*)(Yw + (size_t)orow * 1024 + c8) = pack8(ov); }
#undef TROW
#undef SLOAD
#undef SWRITE
#undef SWAIT
#undef RESC
}
}

__device__ __forceinline__ void phase_attention(const Params& p, int l, unsigned char* lds, bool dry = false) {
  const bf16_t* Qb = (const bf16_t*)(p.ws + WS_Q); const bf16_t* Kb = (const bf16_t*)(p.ws + WS_K); const bf16_t* Vb = (const bf16_t*)(p.ws + WS_V);
  bf16_t* U = (bf16_t*)(p.ws + WS_U);
  const int nitems = 512 + (l < DEPTH - 1 ? 32 : 0);
  for (int it = blockIdx.x; it < nitems; it += gridDim.x) {
    __syncthreads();
    int qrow0, h, b, nlt;
    if (it < 512) { const int cc_ = it & 255, rd_ = it >> 8, slot_ = cc_ >> 3, pair_ = (cc_ & 7) * 4 + rd_ * 2 + (slot_ >> 4);
      const int qb = slot_ & 15; h = pair_ & 7; b = pair_ >> 3; qrow0 = b * 4096 + qb * 256; nlt = 64; }
    else { const int j = it - 512; h = j & 7; b = j >> 3; qrow0 = NLAT + b * 256; nlt = 0; }
    att::attn_body(Qb, Kb, Vb, U, (bf16_t*)(p.ws + WS_YC), qrow0, h, b * 4096, nlt, NLAT + b * 256, 4, lds, dry, p.in[18] + l * 192, (const float*)(p.ws + WS_ROPE), it < 512);
  }
}

#define XB_TMO      128
#define XB_XCNT(j)  (256  + 64 * (j))
#define XB_XSUB(j)  (1280 + 64 * (j))
#define XB_XGEN(j)  (2304 + 64 * (j))
#define XB_TOP      3328
#define XB_TOPGEN   3392
constexpr int XCD_BAR_WORDS = 3456;
#define XB_SPIN_CAP (1u << 18)

__device__ __forceinline__ unsigned xb_ld(unsigned* p)              { return __hip_atomic_load(p, __ATOMIC_RELAXED, __HIP_MEMORY_SCOPE_AGENT); }
__device__ __forceinline__ unsigned xb_add(unsigned* p, unsigned v) { return __hip_atomic_fetch_add(p, v, __ATOMIC_RELAXED, __HIP_MEMORY_SCOPE_AGENT); }
__device__ __forceinline__ unsigned xb_xcc_id() { return (unsigned)__builtin_amdgcn_s_getreg((3 << 11) | 20) & 0xFu; }
#define XB_SPIN(cond, bar) do { unsigned _sp = 0; while (cond) { __builtin_amdgcn_s_sleep(1); \
    if ((++_sp & 255u) == 0u) { if (xb_ld(&(bar)[XB_TMO])) break; if (_sp > XB_SPIN_CAP) { atomicAdd(&(bar)[XB_TMO], 1u); break; } } } } while (0)

struct XcdBarrier {
    unsigned* bar; unsigned x;
    volatile LAS unsigned* st;
};

__device__ __forceinline__ XcdBarrier xcd_barrier_post(unsigned* bar, volatile LAS unsigned* st) {
    XcdBarrier b; b.bar = bar; b.x = xb_xcc_id(); b.st = st;
    if (threadIdx.x == 0) (void)xb_add(&bar[XB_XCNT(b.x)], 1u);
    return b;
}
__device__ __forceinline__ void xcd_barrier_complete(unsigned* bar, unsigned x, unsigned& nloc, unsigned& nx) {
    const unsigned G = gridDim.x * gridDim.y * gridDim.z;
    unsigned sum, cnt, mine, sp = 0u;
    for (;;) {
        sum = 0u; cnt = 0u; mine = 0u;
#pragma unroll
        for (unsigned j = 0; j < 16; ++j) { const unsigned c = xb_ld(&bar[XB_XCNT(j)]); sum += c; cnt += (c > 0u) ? 1u : 0u; mine = (j == x) ? c : mine; }
        if (sum == G) break;
        __builtin_amdgcn_s_sleep(1);
        if ((++sp & 255u) == 0u) { if (xb_ld(&bar[XB_TMO])) break; if (sp > XB_SPIN_CAP) { atomicAdd(&bar[XB_TMO], 1u); break; } }
    }
    nloc = mine > 0u ? mine : 1u; nx = cnt > 0u ? cnt : 1u;
}

__device__ __forceinline__ void xcd_barrier(const XcdBarrier& b) {
    asm volatile("s_waitcnt vmcnt(0)" ::: "memory");
    __syncthreads();
    if (threadIdx.x == 0) {
        unsigned* bar = b.bar;
        __builtin_amdgcn_s_waitcnt(0);
        unsigned nloc = b.st[0], nx = b.st[1];
        if (nloc == 0u) { xcd_barrier_complete(bar, b.x, nloc, nx); b.st[0] = nloc; b.st[1] = nx; }
        const unsigned old = xb_add(&bar[XB_XSUB(b.x)], 1u);
        const unsigned gen = old / nloc;
        if (old + 1u == (gen + 1u) * nloc) {
            __builtin_amdgcn_fence(__ATOMIC_RELEASE, "agent");
            asm volatile("s_waitcnt vmcnt(0)" ::: "memory");
            const unsigned og = xb_add(&bar[XB_TOP], 1u);
            const unsigned tg = og / nx;
            if (og + 1u == (tg + 1u) * nx) xb_add(&bar[XB_TOPGEN], 1u);
            else XB_SPIN(xb_ld(&bar[XB_TOPGEN]) == tg, bar);
            __builtin_amdgcn_fence(__ATOMIC_ACQUIRE, "agent");
            xb_add(&bar[XB_XGEN(b.x)], 1u);
            asm volatile("s_waitcnt vmcnt(0)" ::: "memory");
        } else {
            XB_SPIN(xb_ld(&bar[XB_XGEN(b.x)]) == gen, bar);
            __builtin_amdgcn_fence(__ATOMIC_ACQUIRE, "agent");
            asm volatile("s_waitcnt vmcnt(0)" ::: "memory");
        }
    }
    __syncthreads();
}

#ifndef PH_MASK
#define PH_MASK 0xFFFF
#endif
#ifndef REP_MASK
#define REP_MASK 0
#endif
#define PH(i) for (int rep_ = 0; rep_ < 1 + ((REP_MASK >> (i)) & 1); ++rep_) if constexpr ((PH_MASK >> (i)) & 1)
#define GSYNC() xcd_barrier(xb)
__global__ void __launch_bounds__(512, 2) fwd_megakernel(Params p) {
  extern __shared__ __attribute__((aligned(16))) unsigned char lds[];
  cg::grid_group grid = cg::this_grid();
  LAS unsigned char* ldsl = (LAS unsigned char*)lds;
  const int G = gridDim.x, c = blockIdx.x;
  bf16_t* U = (bf16_t*)(p.ws + WS_U);
  volatile LAS unsigned* bst = (volatile LAS unsigned*)(ldsl + LDS_BYTES - 16);
  if (threadIdx.x < 4) bst[threadIdx.x] = 0u;
  __syncthreads();
  const XcdBarrier xb = xcd_barrier_post((unsigned*)(p.ws + WS_BAR), bst);
  PH(0) phase_mod(p, lds);
  GSYNC();
  { const int i_ = blockIdx.x * 512 + threadIdx.x;
    if (i_ < DEPTH * 5 * 3072) { const float* pp = (const float*)(p.ws + WS_K) + i_; float sacc = 0.f;
      for (int j_ = 0; j_ < 32; ++j_) sacc += pp[(size_t)j_ * (DEPTH * 5 * 3072)];
      ((float*)(p.ws + WS_MOD))[i_] = sacc; } }
  asm volatile("s_waitcnt vmcnt(0)" ::: "memory"); grid.sync();
  for (int l = 0; l < DEPTH; ++l) {
    const float* mod = (const float*)(p.ws + WS_MOD) + (size_t)l * 5 * 3072;
    PH(1) phase_norm_convert(p, l, lds);
    GSYNC();
    PH(2) {
      SchedSimple S{(const char*)(p.ws + WS_H), (const char*)(p.ws + WS_WIN), NR / 256, LDU / 256, G, c, (size_t)256 * 1024 * 2, (size_t)256 * 1024 * 2};
      pg8::EpiRow<FStoreBf16> E{{U, LDU}};
      pg8::gemm_phase(ldsl, 1024, 1024, 1024, S, E);
    }
    GSYNC();
    PH(3) phase_prep(p, l, rep_ < ((REP_MASK >> 3) & 1));
    PH(4) phase_gla_intra(p, l, lds, c, G);
    GSYNC();
    PH(9) {
      { SchedSimple S{(const char*)(p.ws + WS_CN), (const char*)(p.ws + WS_WQ), NR / 256, 1536 / 256, G, c, (size_t)256 * 512 * 2, (size_t)256 * 384 * 2};
        pg8::EpiRow<FStoreBf16> E{{(bf16_t*)(p.ws + WS_Q), LDQ}};
        pg8::gemm_phase(ldsl, 384, 512, 384, S, E); }
      { SchedSimple S{(const char*)(p.ws + WS_CN) + 384 * 2, (const char*)(p.ws + WS_WKV), NR / 256, 2048 / 256, G, c, (size_t)256 * 512 * 2, (size_t)256 * 256 * 2};
        pg8::EpiRow<FStoreKV> E{{(bf16_t*)(p.ws + WS_K), (bf16_t*)(p.ws + WS_V)}};
        pg8::gemm_phase(ldsl, 256, 512, 256, S, E); }
      __syncthreads();
      for (int it = c; it < 256; it += G) phase_gla_inter(p, l, lds, it);
    }
    GSYNC();
    PH(5) phase_qknorm_yb(p, l, rep_ < ((REP_MASK >> 5) & 1));
    GSYNC();
    PH(6) phase_attention(p, l, lds, rep_ < ((REP_MASK >> 6) & 1));
    GSYNC();
    PH(7) {
      SchedMerge S{(const char*)(p.ws + WS_YA), (const char*)(p.ws + WS_YB), (const char*)(p.ws + WS_YC), (const char*)(p.ws + WS_WBR), G, c, (l == DEPTH - 1) ? 0 : 48, (size_t)256 * 1024 * 2, (size_t)256 * 1024 * 2};
      pg8::EpiRow<FMerge> E{{U, (bf16_t*)(p.ws + WS_H), (bf16_t*)(p.ws + WS_MC)}};
      pg8::gemm_phase(ldsl, 1024, 1024, 1024, S, E);
      if (l + 1 < DEPTH && G > 48 && c >= 48) convert_range(p, l + 1, lds, 0, 3280, c - 48, G - 48);
    }
    GSYNC();
    PH(8) {
      SchedOut S{(const char*)(p.ws + WS_H), (const char*)(p.ws + WS_MC), (const char*)(p.ws + WS_WOUT), G, c, (l == DEPTH - 1) ? 0 : 48, (size_t)256 * 1024 * 2};
      pg8::EpiRow<FOut> E{{l == 0 ? p.in[0] : p.out, p.out, (float*)(p.ws + WS_Q), mod, l, rep_ < ((REP_MASK >> 8) & 1)}};
      pg8::gemm_phase(ldsl, 1024, 1024, 1024, S, E);
      if (l + 1 < DEPTH && G > 48 && c >= 48) convert_range(p, l + 1, lds, 3280, 4048, c - 48, G - 48);
    }
    GSYNC();
  }
}

extern "C" void kernel_launch(void* const* d_in, const int* in_sizes, int n_in, void* d_out, int out_size, void* d_ws, size_t ws_size, hipStream_t stream) {
  static int grid = 0;
  if (grid == 0) {
    if (n_in != 24 || out_size != NLAT * DM || ws_size < WS_END) { fprintf(stderr, "kernel_launch: unexpected shapes (n_in %d out %d ws %zu, need ws >= %zu)\n", n_in, out_size, ws_size, (size_t)WS_END); grid = -1; return; }
    int dev = 0, cus = 0, per_cu = 0;
    hipGetDevice(&dev); hipDeviceGetAttribute(&cus, hipDeviceAttributeMultiprocessorCount, dev);
    if (hipFuncSetAttribute((const void*)fwd_megakernel, hipFuncAttributeMaxDynamicSharedMemorySize, LDS_BYTES) != hipSuccess) { fprintf(stderr, "kernel_launch: hipFuncSetAttribute failed\n"); grid = -1; return; }
    if (hipOccupancyMaxActiveBlocksPerMultiprocessor(&per_cu, (const void*)fwd_megakernel, 512, LDS_BYTES) != hipSuccess || per_cu < 1) { fprintf(stderr, "kernel_launch: occupancy query says %d\n", per_cu); per_cu = 1; }
    (void)hipGetLastError();
    grid = cus;
  }
  if (grid < 0) return;
  hipMemsetAsync((char*)d_ws + WS_BAR, 0, (size_t)3456 * 4, stream);
#ifdef LDS_PROBE
  hipMemsetAsync((char*)d_ws + WS_ROPE + 8192, 0, 256, stream);
#endif
  Params p{};
  for (int i = 0; i < 24; ++i) p.in[i] = (const float*)d_in[i];
  p.out = (float*)d_out; p.ws = (unsigned char*)d_ws;
  void* args[] = {&p};
  hipError_t e = hipLaunchCooperativeKernel((const void*)fwd_megakernel, dim3(grid), dim3(512), args, LDS_BYTES, stream);
  if (e != hipSuccess) fprintf(stderr, "cooperative launch failed: %s (grid %d)\n", hipGetErrorString(e), grid);
}
```
